# Optimizing an MI355X kernel written in HIP

```python
import jax
import jax.numpy as jnp
from jax import lax
import numpy as np


D_MODEL = 1024
BATCH = 4
SEQ = 8192
DEPTH = 4

GRID_W = 64
CTX_LEN = 256
EPS = 1e-6
F_MIN = 1e-6
F32 = jnp.float32
N_MOD = 9
D_FF = 2816
HG_HEADS = 4
HG_DK = 64
HG_DV = 64
HG_CHUNK = 64
MLA_HEADS = 8
MLA_Q_RANK = 384
MLA_KV_RANK = 256
MLA_NOPE = 64
MLA_ROPE = 32
MLA_V = 64
MLA_QK = MLA_NOPE + MLA_ROPE
ATTN_BLOCK = 128
ROPE_BASE = 10000.0
POOL_WINDOWS = (2, 4, 8, 16)
POOL_CH = 64
HG_K = HG_HEADS * HG_DK
HG_WIDTH = HG_HEADS * HG_DV
MLA_WIDTH = MLA_HEADS * MLA_V
POOL_WIDTH = len(POOL_WINDOWS) * POOL_CH
MIX_WIDTH = HG_WIDTH + MLA_WIDTH + POOL_WIDTH
IN_SPLITS = (HG_K, HG_K, HG_K, HG_WIDTH, HG_WIDTH, MLA_Q_RANK, MLA_KV_RANK, MLA_ROPE, POOL_WIDTH)
IN_WIDTH = sum(IN_SPLITS)

kernel_name = 'hybrid_hgrn2_mla_pool_macaron_dit'


def rms_norm(x, gain):
    xf = x.astype(F32)
    y = xf * lax.rsqrt(jnp.mean(xf * xf, axis=-1, keepdims=True) + EPS)
    return (y * gain.astype(F32)).astype(x.dtype)


def modulated_rms_norm(x, shift, scale):
    xf = x.astype(F32)
    y = xf * lax.rsqrt(jnp.mean(xf * xf, axis=-1, keepdims=True) + EPS)
    return (y * (1.0 + scale.astype(F32)) + shift.astype(F32)).astype(x.dtype)


def swiglu(h, w_in, w_out):
    g, u = jnp.split(h @ w_in, 2, axis=-1)
    return (jax.nn.silu(g) * u) @ w_out


def split_cols(p):
    return jnp.split(p, [int(o) for o in np.cumsum(IN_SPLITS)[:-1]], axis=-1)


def axial_rope(rows):
    row = jnp.repeat(jnp.arange(rows), GRID_W).astype(F32)
    col = jnp.tile(jnp.arange(GRID_W), rows).astype(F32)
    n_freq = MLA_ROPE // 4
    inv_freq = ROPE_BASE ** (-jnp.arange(n_freq, dtype=F32) / n_freq)
    ang = jnp.concatenate([row[:, None] * inv_freq, col[:, None] * inv_freq], axis=-1)
    return jnp.cos(ang)[:, None, :], jnp.sin(ang)[:, None, :]


def rotate_tail(x, cos, sin):
    nope, pe = x[..., :MLA_NOPE], x[..., MLA_NOPE:]
    half = MLA_ROPE // 2
    x1, x2 = pe[..., :half].astype(F32), pe[..., half:].astype(F32)
    rot = jnp.concatenate([x1 * cos - x2 * sin, x1 * sin + x2 * cos], axis=-1).astype(x.dtype)
    return jnp.concatenate([nope, rot], axis=-1)


def to_heads(a, n_heads):
    b, t, _ = a.shape
    return a.reshape(b, t, n_heads, -1).transpose(0, 2, 1, 3)


def hgrn2_gates(z, lb):
    zf = z.astype(F32)
    f = lb + (1.0 - lb) * jax.nn.sigmoid(zf)
    log_f = jnp.log(jnp.clip(f, F_MIN, 1.0))
    k = 1.0 - f
    return log_f, k


def hgrn2_inputs(q_z, f_fwd_z, f_bwd_z, i_z, lb_fwd, lb_bwd):
    q = to_heads(jax.nn.silu(q_z.astype(F32)), HG_HEADS)
    v = to_heads(i_z.astype(F32), HG_HEADS)
    lf_f, k_f = hgrn2_gates(f_fwd_z, lb_fwd)
    lf_b, k_b = hgrn2_gates(f_bwd_z, lb_bwd)
    return (q, v, to_heads(lf_f, HG_HEADS), to_heads(k_f, HG_HEADS),
            to_heads(lf_b, HG_HEADS), to_heads(k_b, HG_HEADS))


def gla_chunk_scan(q, k, v, log_f, s0):
    b_, h_, t_, _ = q.shape
    dv = v.shape[-1]
    n = t_ // HG_CHUNK

    def chunks(a):
        return jnp.moveaxis(a.reshape(b_, h_, n, HG_CHUNK, a.shape[-1]), 2, 0)

    incl = jnp.tril(jnp.ones((HG_CHUNK, HG_CHUNK), dtype=bool))[:, :, None]

    def step(s, blk):
        qc, kc, vc, lfc = blk
        b = jnp.cumsum(lfc, axis=2)
        o = jnp.einsum('bhck,bhkv->bhcv', qc * jnp.exp(b), s)
        rel = jnp.where(incl, b[:, :, :, None, :] - b[:, :, None, :, :], 0.0)
        decay = jnp.where(incl, jnp.exp(rel), 0.0)
        att = jnp.einsum('bhck,bhcsk,bhsk->bhcs', qc, decay, kc)
        o = o + jnp.einsum('bhcs,bhsv->bhcv', att, vc)
        b_end = b[:, :, -1:, :]
        s = jnp.exp(b_end[:, :, 0, :, None]) * s + jnp.einsum('bhsk,bhsv->bhkv', kc * jnp.exp(b_end - b), vc)
        return s, o

    s_fin, o = lax.scan(step, s0, (chunks(q), chunks(k), chunks(v), chunks(log_f)))
    return jnp.moveaxis(o, 0, 2).reshape(b_, h_, t_, dv), s_fin


def hgrn2_bidir(q, v, lf_f, k_f, lf_b, k_b, s_f0, s_b0):
    o_f, s_f = gla_chunk_scan(q, k_f, v, lf_f, s_f0)
    rev = lambda a: jnp.flip(a, axis=2)
    o_b, s_b = gla_chunk_scan(rev(q), rev(k_b), rev(v), rev(lf_b), s_b0)
    return o_f + rev(o_b), s_f, s_b


def hgrn2_readout(o, g_z, gain, dtype):
    b_, h_, t_, dv = o.shape
    o = o * lax.rsqrt(jnp.mean(o * o, axis=-1, keepdims=True) + EPS) * gain.astype(F32)
    o = o.transpose(0, 2, 1, 3).reshape(b_, t_, h_ * dv)
    return (o * jax.nn.silu(g_z.astype(F32))).astype(dtype)


def mla_queries(cq, q_a_gain, w_uq, q_gain, rope):
    b_, t_, _ = cq.shape
    q = (rms_norm(cq, q_a_gain) @ w_uq).reshape(b_, t_, MLA_HEADS, MLA_QK)
    q = rms_norm(q, q_gain)
    if rope is not None:
        q = rotate_tail(q, rope[0], rope[1])
    return q


def mla_keys_values(ckv, kpe, kv_a_gain, w_ukv, k_gain, rope):
    b_, t_, _ = ckv.shape
    kv = (rms_norm(ckv, kv_a_gain) @ w_ukv).reshape(b_, t_, MLA_HEADS, MLA_NOPE + MLA_V)
    k_nope, v = kv[..., :MLA_NOPE], kv[..., MLA_NOPE:]
    k_pe = jnp.broadcast_to(kpe[:, :, None, :], (b_, t_, MLA_HEADS, MLA_ROPE)).astype(k_nope.dtype)
    k = rms_norm(jnp.concatenate([k_nope, k_pe], axis=-1), k_gain)
    if rope is not None:
        k = rotate_tail(k, rope[0], rope[1])
    return k, v


def block_attention(q, k, v):
    b_, t_, h_, dq = q.shape
    n = t_ // ATTN_BLOCK
    scale = dq ** -0.5
    qb = jnp.moveaxis(q.reshape(b_, n, ATTN_BLOCK, h_, dq), 1, 0)

    def attend(qblk):
        s = jnp.einsum('bqhd,bkhd->bhqk', qblk, k).astype(F32) * scale
        p = jax.nn.softmax(s, axis=-1).astype(v.dtype)
        return jnp.einsum('bhqk,bkhd->bqhd', p, v)

    o = lax.map(attend, qb)
    return jnp.moveaxis(o, 0, 1).reshape(b_, t_, h_ * v.shape[-1])


def multiscale_pool(u, w_pool, pool_scale):
    b_, t_, _ = u.shape
    n_g = len(POOL_WINDOWS)
    ug = u.reshape(b_, t_, n_g, POOL_CH).astype(F32)
    csum = jnp.concatenate([jnp.zeros((b_, 1, n_g, POOL_CH), F32), jnp.cumsum(ug, axis=1)], axis=1)
    pos = jnp.arange(t_)
    means = []
    for g, w in enumerate(POOL_WINDOWS):
        lo = jnp.clip(pos - w // 2, 0, t_ - 1)
        hi = jnp.clip(pos + w - 1 - w // 2, 0, t_ - 1)
        cs = csum[:, :, g]
        cnt = (hi - lo + 1).astype(F32)[None, :, None]
        means.append((cs[:, hi + 1] - cs[:, lo]) / cnt)
    pooled = (jnp.stack(means, axis=2) - ug).astype(u.dtype)
    y = jnp.einsum('btgc,gcd->btgd', pooled, w_pool).reshape(b_, t_, n_g * POOL_CH)
    return y * pool_scale


def token_mixers(parts_l, parts_c, lb_fwd, lb_bwd, hg_gain, q_a_gain, w_uq, kv_a_gain, w_ukv,
                 q_gain, k_gain, w_pool, pool_scale, rope, need_ctx_out):
    q_l, ff_l, fb_l, i_l, g_l, cq_l, ckv_l, kpe_l, pool_l = parts_l
    q_c, ff_c, fb_c, i_c, g_c, cq_c, ckv_c, kpe_c, pool_c = parts_c
    dtype = q_l.dtype
    b_ = q_l.shape[0]
    s0 = jnp.zeros((b_, HG_HEADS, HG_DK, HG_DV), F32)
    o_c, s_f, s_b = hgrn2_bidir(*hgrn2_inputs(q_c, ff_c, fb_c, i_c, lb_fwd, lb_bwd), s0, s0)
    o_l, _, _ = hgrn2_bidir(*hgrn2_inputs(q_l, ff_l, fb_l, i_l, lb_fwd, lb_bwd), s_f, s_b)
    hg_out = hgrn2_readout(o_l, g_l, hg_gain, dtype)
    k_c, v_c = mla_keys_values(ckv_c, kpe_c, kv_a_gain, w_ukv, k_gain, None)
    k_l, v_l = mla_keys_values(ckv_l, kpe_l, kv_a_gain, w_ukv, k_gain, rope)
    q_lat = mla_queries(cq_l, q_a_gain, w_uq, q_gain, rope)
    att_out = block_attention(q_lat, jnp.concatenate([k_l, k_c], axis=1), jnp.concatenate([v_l, v_c], axis=1))
    pool_out = multiscale_pool(pool_l, w_pool, pool_scale)
    mix_l = jnp.concatenate([hg_out, att_out.astype(dtype), pool_out.astype(dtype)], axis=-1)
    if not need_ctx_out:
        return mix_l, None
    hg_c = hgrn2_readout(o_c, g_c, hg_gain, dtype)
    att_c = block_attention(mla_queries(cq_c, q_a_gain, w_uq, q_gain, None), k_c, v_c)
    pool_cx = multiscale_pool(pool_c, w_pool, pool_scale)
    mix_c = jnp.concatenate([hg_c, att_c.astype(dtype), pool_cx.astype(dtype)], axis=-1)
    return mix_l, mix_c


def setup_inputs(seed: int = 0) -> dict:
    key = jax.random.key(seed)
    ks = jax.random.split(key, 22)
    nrm = lambda k, shape, s: jax.random.normal(k, shape, F32) * s
    gain = lambda k, shape: 1.0 + 0.1 * jax.random.normal(k, shape, F32)
    return {
        'x': nrm(ks[0], (BATCH, SEQ, D_MODEL), 1.0),
        'c': nrm(ks[1], (BATCH, D_MODEL), 1.0),
        'ctx': nrm(ks[2], (BATCH, CTX_LEN, D_MODEL), 1.0),
        'c_ctx': nrm(ks[3], (D_MODEL,), 1.0),
        'w_mod': nrm(ks[4], (DEPTH, D_MODEL, N_MOD * D_MODEL), 0.5 * D_MODEL ** -0.5),
        'b_mod': nrm(ks[5], (DEPTH, N_MOD * D_MODEL), 0.01),
        'ffn1_w_in': nrm(ks[6], (DEPTH, D_MODEL, 2 * D_FF), D_MODEL ** -0.5),
        'ffn1_w_out': nrm(ks[7], (DEPTH, D_FF, D_MODEL), D_FF ** -0.5),
        'w_in': nrm(ks[8], (DEPTH, D_MODEL, IN_WIDTH), D_MODEL ** -0.5),
        'w_out': nrm(ks[9], (DEPTH, MIX_WIDTH, D_MODEL), MIX_WIDTH ** -0.5),
        'hg_lb_logits': nrm(ks[10], (DEPTH, 2, HG_K), 0.1),
        'hg_out_gain': gain(ks[11], (DEPTH, HG_DV)),
        'mla_q_a_gain': gain(ks[12], (DEPTH, MLA_Q_RANK)),
        'mla_w_uq': nrm(ks[13], (DEPTH, MLA_Q_RANK, MLA_HEADS * MLA_QK), MLA_Q_RANK ** -0.5),
        'mla_kv_a_gain': gain(ks[14], (DEPTH, MLA_KV_RANK)),
        'mla_w_ukv': nrm(ks[15], (DEPTH, MLA_KV_RANK, MLA_HEADS * (MLA_NOPE + MLA_V)), MLA_KV_RANK ** -0.5),
        'mla_q_gain': gain(ks[16], (DEPTH, MLA_QK)),
        'mla_k_gain': gain(ks[17], (DEPTH, MLA_QK)),
        'pool_w': nrm(ks[18], (DEPTH, len(POOL_WINDOWS), POOL_CH, POOL_CH), POOL_CH ** -0.5),
        'pool_scale': gain(ks[19], (DEPTH, POOL_WIDTH)),
        'ffn2_w_in': nrm(ks[20], (DEPTH, D_MODEL, 2 * D_FF), D_MODEL ** -0.5),
        'ffn2_w_out': nrm(ks[21], (DEPTH, D_FF, D_MODEL), D_FF ** -0.5),
    }


def reference(x, c, ctx, c_ctx, w_mod, b_mod, ffn1_w_in, ffn1_w_out, w_in, w_out, hg_lb_logits,
              hg_out_gain, mla_q_a_gain, mla_w_uq, mla_kv_a_gain, mla_w_ukv, mla_q_gain, mla_k_gain,
              pool_w, pool_scale, ffn2_w_in, ffn2_w_out):
    b_, n_lat, d_ = x.shape
    rows = n_lat // GRID_W
    rope = axial_rope(rows)
    p = jax.nn.softmax(hg_lb_logits.astype(F32), axis=0)
    lower_bounds = jnp.cumsum(p, axis=0) - p[0]
    c_act = jax.nn.silu(c)
    cc_act = jax.nn.silu(c_ctx)
    xl, xc = x, ctx
    for l in range(DEPTH):
        need_ctx_out = l < DEPTH - 1
        mod_l = (c_act @ w_mod[l] + b_mod[l]).reshape(b_, N_MOD, 1, d_)
        mod_c = (cc_act @ w_mod[l] + b_mod[l]).reshape(N_MOD, 1, 1, d_)
        ml = [mod_l[:, j] for j in range(N_MOD)]
        mc = [mod_c[j] for j in range(N_MOD)]
        xl = xl + ml[2] * (0.5 * swiglu(modulated_rms_norm(xl, ml[0], ml[1]), ffn1_w_in[l], ffn1_w_out[l]))
        xc = xc + mc[2] * (0.5 * swiglu(modulated_rms_norm(xc, mc[0], mc[1]), ffn1_w_in[l], ffn1_w_out[l]))
        parts_l = split_cols(modulated_rms_norm(xl, ml[3], ml[4]) @ w_in[l])
        parts_c = split_cols(modulated_rms_norm(xc, mc[3], mc[4]) @ w_in[l])
        mix_l, mix_c = token_mixers(parts_l, parts_c, lower_bounds[l, 0], lower_bounds[l, 1], hg_out_gain[l],
                                    mla_q_a_gain[l], mla_w_uq[l], mla_kv_a_gain[l], mla_w_ukv[l],
                                    mla_q_gain[l], mla_k_gain[l], pool_w[l], pool_scale[l], rope, need_ctx_out)
        xl = xl + ml[5] * (mix_l @ w_out[l])
        xl = xl + ml[8] * (0.5 * swiglu(modulated_rms_norm(xl, ml[6], ml[7]), ffn2_w_in[l], ffn2_w_out[l]))
        if need_ctx_out:
            xc = xc + mc[5] * (mix_c @ w_out[l])
            xc = xc + mc[8] * (0.5 * swiglu(modulated_rms_norm(xc, mc[6], mc[7]), ffn2_w_in[l], ffn2_w_out[l]))
    return xl
```

```cpp
#include <hip/hip_runtime.h>
#include <hip/hip_cooperative_groups.h>
#include <cstdio>
#include <cstdint>
namespace cg = cooperative_groups;
#ifndef PROBE_ATTN_REP
#define PROBE_ATTN_REP 1
#endif
#ifndef PROBE_REP5
#define PROBE_REP5 1
#endif
#ifndef PROBE_REPC
#define PROBE_REPC 1
#endif
namespace pg8 {
#define PG8_LAS __attribute__((address_space(3)))
typedef unsigned short bf16_t;
typedef short bf16x8 __attribute__((ext_vector_type(8)));
typedef float f32x4 __attribute__((ext_vector_type(4)));
typedef unsigned u32x4 __attribute__((ext_vector_type(4)));
constexpr int BM = 256, BK = 64, HALF = 128, HTB = HALF * BK * 2  , STAGE_BYTES = 8 * HTB, NXCD = 8, WGM = 8;

__host__ __device__ __forceinline__ int lds_byte(int r, int c) { const int st = (r >> 4) * 2 + (c >> 5), rr = r & 15, cc = c & 31, ob = rr * 64 + cc * 2; return st * 1024 + (ob ^ (((ob >> 9) & 1) << 5)); }
__host__ __device__ __forceinline__ void stage_rc(int b, int& R, int& C) { const int st = b / 1024, sb = b % 1024, swz = sb ^ (((sb >> 9) & 1) << 5); R = (st >> 1) * 16 + swz / 64; C = (st & 1) * 32 + (swz % 64) / 2; }
__host__ __device__ __forceinline__ int perm32(int rho) { const int n = rho >> 4, i = rho & 15; return 8 * (i >> 2) + 4 * n + (i & 3); }

struct Unit { int pm, pn; };
struct Gemm { const bf16_t* A; const bf16_t* Bt; int M, N, K; };

struct StaticOrder {
    int nM, nN, nwg, G, c;
    __host__ __device__ void init(int M, int N, int G_, int c_) { nM = M / BM; nN = N / BM; nwg = nM * nN; G = G_; c = c_; }
    __host__ __device__ bool next(int i, Unit& u) const {
        const long L = (long)i * G + c; if (L >= nwg) return false;
        int wgid = (int)L; { const int q = nwg / NXCD, r = nwg % NXCD, xcd = wgid % NXCD, off = wgid / NXCD; wgid = (xcd < r ? xcd * (q + 1) : r * (q + 1) + (xcd - r) * q) + off; }
        const int nig = WGM * nN, gid = wgid / nig, fm = gid * WGM, gsz = (nM - fm) < WGM ? (nM - fm) : WGM;
        u.pm = fm + ((wgid % nig) % gsz); u.pn = (wgid % nig) / gsz; return true;
    }
    __device__ __forceinline__ void a_ready(const Unit&) const {}
    __device__ __forceinline__ void done(const Unit&) const {}
};

__device__ __forceinline__ unsigned cvt_pk_bf16(float lo, float hi) { unsigned r; asm volatile("v_cvt_pk_bf16_f32 %0, %1, %2" : "=v"(r) : "v"(lo), "v"(hi)); return r; }
struct EpiBf16P {
    static constexpr bool PERM = true, AFTER_DRAIN = false;
    bf16_t* O; int ldc;
    __device__ __forceinline__ void operator()(const f32x4 (&acc)[2][2][4][2], const Unit& u, int wr, int wc, int fr, int fq) const {
        const int row0 = u.pm * BM + wr * 64 + fr; const int col0 = u.pn * BM + wc * 32 + 8 * fq;
#pragma unroll
        for (int ai = 0; ai < 2; ++ai)
#pragma unroll
            for (int m = 0; m < 4; ++m) { bf16_t* rowp = O + (size_t)(row0 + ai * HALF + m * 16) * ldc + col0;
#pragma unroll
                for (int bj = 0; bj < 2; ++bj) { const f32x4 v0 = acc[ai][bj][m][0], v1 = acc[ai][bj][m][1];
                    u32x4 w; w.x = cvt_pk_bf16(v0[0], v0[1]); w.y = cvt_pk_bf16(v0[2], v0[3]); w.z = cvt_pk_bf16(v1[0], v1[1]); w.w = cvt_pk_bf16(v1[2], v1[3]);
                    *(u32x4*)(rowp + bj * HALF) = w; } }
    }
};
__device__ __forceinline__ float silu_f(float g) { return g * __builtin_amdgcn_rcpf(1.0f + __builtin_amdgcn_exp2f(-1.4426950408889634f * g)); }
struct EpiSwiglu {
    static constexpr bool PERM = true, AFTER_DRAIN = false;
    bf16_t* H; int ldh;
    __device__ __forceinline__ void operator()(const f32x4 (&acc)[2][2][4][2], const Unit& u, int wr, int wc, int fr, int fq) const {
        const int row0 = u.pm * BM + wr * 64 + fr; const int col0 = u.pn * HALF + wc * 32 + 8 * fq;
#pragma unroll
        for (int ai = 0; ai < 2; ++ai)
#pragma unroll
            for (int m = 0; m < 4; ++m) { bf16_t* rowp = H + (size_t)(row0 + ai * HALF + m * 16) * ldh + col0;
                const f32x4 g0 = acc[ai][0][m][0], g1 = acc[ai][0][m][1], u0 = acc[ai][1][m][0], u1 = acc[ai][1][m][1];
                u32x4 w; w.x = cvt_pk_bf16(silu_f(g0[0]) * u0[0], silu_f(g0[1]) * u0[1]); w.y = cvt_pk_bf16(silu_f(g0[2]) * u0[2], silu_f(g0[3]) * u0[3]);
                w.z = cvt_pk_bf16(silu_f(g1[0]) * u1[0], silu_f(g1[1]) * u1[1]); w.w = cvt_pk_bf16(silu_f(g1[2]) * u1[2], silu_f(g1[3]) * u1[3]);
                *(u32x4*)rowp = w; }
    }
};
struct EpiResid {
    static constexpr bool PERM = false, AFTER_DRAIN = false;
    const float* base_l; const float* base_c; float* out_l; float* out_c; const float* gate; int gstride; float coef;
    __device__ __forceinline__ void operator()(const f32x4 (&acc)[2][2][4][2], const Unit& u, int wr, int wc, int fr, int fq) const {
        const int trow = u.pm * BM; const bool lat = trow < 32768;
        const float* bp = lat ? base_l + (size_t)trow * 1024 : base_c + (size_t)(trow - 32768) * 1024;
        float* op = lat ? out_l + (size_t)trow * 1024 : out_c + (size_t)(trow - 32768) * 1024;
        const float* gp = gate + (size_t)(lat ? (trow >> 13) : 4) * gstride;
        const int rloc = wr * 64 + fr; const int col0 = u.pn * BM + wc * 32 + 4 * fq;
#pragma unroll
        for (int bj = 0; bj < 2; ++bj)
#pragma unroll
            for (int n = 0; n < 2; ++n) { const int cc = col0 + bj * HALF + 16 * n; const f32x4 gv = *(const f32x4*)(gp + cc) * coef;
                f32x4 b[2][4];
#pragma unroll
                for (int ai = 0; ai < 2; ++ai)
#pragma unroll
                    for (int m = 0; m < 4; ++m) b[ai][m] = *(const f32x4*)(bp + (size_t)(rloc + ai * HALF + m * 16) * 1024 + cc);
                __builtin_amdgcn_sched_barrier(0);
#pragma unroll
                for (int ai = 0; ai < 2; ++ai)
#pragma unroll
                    for (int m = 0; m < 4; ++m) *(f32x4*)(op + (size_t)(rloc + ai * HALF + m * 16) * 1024 + cc) = b[ai][m] + gv * acc[ai][bj][m][n];
                __builtin_amdgcn_sched_barrier(0); }
    }
};
template <class Epi, class Sched, bool ALIGN_EPI = false, bool SP2 = false>
__device__ __forceinline__ void gemm_phase(PG8_LAS unsigned char* lds, const Gemm g, const Sched& S, const Epi& E) {
    int tid_l = threadIdx.x; asm volatile("" : "+v"(tid_l));
    const int tid = tid_l, wid = __builtin_amdgcn_readfirstlane(tid >> 6), lane = tid & 63, wr = wid >> 2, wc = wid & 3, fr = lane & 15, fq = lane >> 4;
    const int K = g.K, nt = K / BK;
    unsigned voffA[2], voffB[2];
#pragma unroll
    for (int i = 0; i < 2; ++i) { int R, C; stage_rc(tid * 16 + i * 8192, R, C); const int Rb = Epi::PERM ? ((R & ~31) + perm32(R & 31)) : R;
        voffA[i] = (unsigned)(R * K + C) * 2u; voffB[i] = (unsigned)(Rb * K + C) * 2u; }
    const size_t kstep = (size_t)(BK * 2);
    const size_t hstep = (size_t)HALF * K * 2;
    const size_t tstep = 2 * hstep;
    const unsigned ldsw = (unsigned)wid * 1024u;
    const int aoff = lds_byte(wr * 64 + fr, fq * 8), boff = lds_byte(wc * 32 + fr, fq * 8);
#define PG8_SA(b, h) (((b) * 2 + (h)) * HTB)
#define PG8_SB(b, h) ((4 + (b) * 2 + (h)) * HTB)
#define PG8_STAGE(bufoff, gbase, voff) do { _Pragma("unroll") for (int _i = 0; _i < 2; ++_i) \
        __builtin_amdgcn_global_load_lds((const unsigned*)((const char*)(gbase) + (voff)[_i]), (PG8_LAS unsigned*)(lds + (bufoff) + ldsw + _i * 8192), 16, 0, 0); } while (0)
#define PG8_LDA(dst, b, h) do { _Pragma("unroll") for (int m = 0; m < 4; ++m) _Pragma("unroll") for (int k = 0; k < 2; ++k) dst[m][k] = *(const PG8_LAS bf16x8*)(lds + PG8_SA(b, h) + aoff + m * 2048 + k * 1024); } while (0)
#define PG8_LDB(dst, b, h) do { _Pragma("unroll") for (int n = 0; n < 2; ++n) _Pragma("unroll") for (int k = 0; k < 2; ++k) dst[n][k] = *(const PG8_LAS bf16x8*)(lds + PG8_SB(b, h) + boff + n * 2048 + k * 1024); } while (0)
#define PG8_MMA(ai, bj, At, Bt) do { __builtin_amdgcn_s_setprio(1); _Pragma("unroll") for (int m = 0; m < 4; ++m) _Pragma("unroll") for (int n = 0; n < 2; ++n) _Pragma("unroll") for (int k = 0; k < 2; ++k) \
        acc[ai][bj][m][n] = __builtin_amdgcn_mfma_f32_16x16x32_bf16(Bt[n][k], At[m][k], acc[ai][bj][m][n], 0, 0, 0); __builtin_amdgcn_s_setprio(0); } while (0)
#define PG8_WAIT_V(n) asm volatile("s_waitcnt vmcnt(" #n ")" ::: "memory")
#define PG8_WAIT_L(n) asm volatile("s_waitcnt lgkmcnt(" #n ")" ::: "memory")
#define PG8_BAR __builtin_amdgcn_s_barrier()
#define PG8_SCHED __builtin_amdgcn_sched_barrier(0)
    Unit cur, nxt; int ui = 0;
    if (!S.next(0, cur)) return;
    f32x4 acc[2][2][4][2];
#pragma unroll
    for (int a = 0; a < 2; ++a)
#pragma unroll
        for (int b = 0; b < 2; ++b)
#pragma unroll
            for (int m = 0; m < 4; ++m)
#pragma unroll
                for (int n = 0; n < 2; ++n) acc[a][b][m][n] = (f32x4){0.f, 0.f, 0.f, 0.f};
    bf16x8 At[4][2], B0[2][2], B1[2][2];
    const char* cA = (const char*)g.A + (size_t)cur.pm * tstep; const char* cB = (const char*)g.Bt + (size_t)cur.pn * tstep;
    S.a_ready(cur);
    if constexpr (SP2) {
        PG8_STAGE(PG8_SB(0, 0), cB, voffB); PG8_STAGE(PG8_SB(0, 1), cB + hstep, voffB); PG8_STAGE(PG8_SA(0, 0), cA, voffA); PG8_STAGE(PG8_SA(0, 1), cA + hstep, voffA);
        if (wr == 1) PG8_BAR;
        PG8_WAIT_V(2); PG8_BAR;
        PG8_STAGE(PG8_SB(1, 0), cB + kstep, voffB); PG8_STAGE(PG8_SA(1, 0), cA + kstep, voffA); PG8_STAGE(PG8_SB(1, 1), cB + hstep + kstep, voffB);
        PG8_WAIT_V(6); PG8_BAR;
    } else {
        PG8_STAGE(PG8_SB(0, 0), cB, voffB); PG8_STAGE(PG8_SA(0, 0), cA, voffA); PG8_STAGE(PG8_SB(0, 1), cB + hstep, voffB); PG8_STAGE(PG8_SA(0, 1), cA + hstep, voffA);
        if (wr == 1) PG8_BAR;
        PG8_WAIT_V(4); PG8_BAR;
        PG8_STAGE(PG8_SB(1, 0), cB + kstep, voffB); PG8_STAGE(PG8_SA(1, 0), cA + kstep, voffA); PG8_STAGE(PG8_SB(1, 1), cB + hstep + kstep, voffB);
        PG8_WAIT_V(6); PG8_BAR;
    }
    for (;;) {
        const bool has_next = S.next(ui + 1, nxt);
        const char* nA = has_next ? (const char*)g.A + (size_t)nxt.pm * tstep : cA; const char* nB = has_next ? (const char*)g.Bt + (size_t)nxt.pn * tstep : cB;
        for (int t = 0; t < nt; t += 2) {
            const bool last = (t == nt - 2);
            const char* a1 = cA + (size_t)(t + 1) * kstep;
            const char* a2 = last ? nA : cA + (size_t)(t + 2) * kstep; const char* b2 = last ? nB : cB + (size_t)(t + 2) * kstep;
            const char* a3 = a2 + kstep; const char* b3 = b2 + kstep;
            if (last && has_next) S.a_ready(nxt);
            if constexpr (SP2) {
            PG8_LDB(B0, 0, 0); PG8_LDB(B1, 0, 1); PG8_SCHED; PG8_LDA(At, 0, 0); PG8_STAGE(PG8_SA(1, 1), a1 + hstep, voffA);
            PG8_WAIT_V(8); PG8_WAIT_L(0); PG8_BAR; PG8_MMA(0, 0, At, B0); PG8_MMA(0, 1, At, B1); PG8_BAR; PG8_SCHED;
            PG8_LDA(At, 0, 1); PG8_STAGE(PG8_SB(0, 0), b2, voffB); PG8_STAGE(PG8_SB(0, 1), b2 + hstep, voffB); PG8_STAGE(PG8_SA(0, 0), a2, voffA);
            PG8_WAIT_V(8); PG8_WAIT_L(0); PG8_BAR; PG8_MMA(1, 0, At, B0); PG8_MMA(1, 1, At, B1); PG8_BAR; PG8_SCHED;
            PG8_LDB(B0, 1, 0); PG8_LDB(B1, 1, 1); PG8_SCHED; PG8_LDA(At, 1, 0); PG8_STAGE(PG8_SA(0, 1), a2 + hstep, voffA);
            PG8_WAIT_V(8); PG8_WAIT_L(0); PG8_BAR; PG8_MMA(0, 0, At, B0); PG8_MMA(0, 1, At, B1); PG8_BAR; PG8_SCHED;
            PG8_LDA(At, 1, 1); PG8_STAGE(PG8_SB(1, 0), b3, voffB); PG8_STAGE(PG8_SB(1, 1), b3 + hstep, voffB); PG8_STAGE(PG8_SA(1, 0), a3, voffA);
            PG8_WAIT_V(8); PG8_WAIT_L(0); PG8_BAR; PG8_MMA(1, 0, At, B0); PG8_MMA(1, 1, At, B1); PG8_BAR; PG8_SCHED;
            } else {
            PG8_LDB(B0, 0, 0); PG8_SCHED; PG8_LDA(At, 0, 0); PG8_STAGE(PG8_SA(1, 1), a1 + hstep, voffA);
            PG8_WAIT_L(8); PG8_BAR; PG8_WAIT_L(0); PG8_MMA(0, 0, At, B0); PG8_BAR; PG8_SCHED;
            PG8_LDB(B1, 0, 1); PG8_STAGE(PG8_SB(0, 0), b2, voffB);
            PG8_BAR; PG8_WAIT_L(0); PG8_MMA(0, 1, At, B1); PG8_BAR;
            PG8_LDA(At, 0, 1); PG8_STAGE(PG8_SA(0, 0), a2, voffA);
            PG8_BAR; PG8_WAIT_L(0); PG8_MMA(1, 0, At, B0); PG8_BAR; PG8_SCHED;
            PG8_STAGE(PG8_SB(0, 1), b2 + hstep, voffB);
            PG8_WAIT_V(6); PG8_BAR; PG8_MMA(1, 1, At, B1); PG8_BAR;
            PG8_LDB(B0, 1, 0); PG8_SCHED; PG8_LDA(At, 1, 0); PG8_STAGE(PG8_SA(0, 1), a2 + hstep, voffA);
            PG8_WAIT_L(8); PG8_BAR; PG8_WAIT_L(0); PG8_MMA(0, 0, At, B0); PG8_BAR; PG8_SCHED;
            PG8_LDB(B1, 1, 1); PG8_STAGE(PG8_SB(1, 0), b3, voffB);
            PG8_BAR; PG8_WAIT_L(0); PG8_MMA(0, 1, At, B1); PG8_BAR;
            PG8_LDA(At, 1, 1); PG8_STAGE(PG8_SA(1, 0), a3, voffA);
            PG8_BAR; PG8_WAIT_L(0); PG8_MMA(1, 0, At, B0); PG8_BAR; PG8_SCHED;
            PG8_STAGE(PG8_SB(1, 1), b3 + hstep, voffB);
            PG8_WAIT_V(6); PG8_BAR; PG8_MMA(1, 1, At, B1); PG8_BAR;
            }
        }
        if constexpr (ALIGN_EPI) { if (wr == 0) PG8_BAR; }
        if constexpr (!Epi::AFTER_DRAIN) { E(acc, cur, wr, wc, fr, fq); S.done(cur); }
        if (!has_next) break;
#pragma unroll
        for (int a = 0; a < 2; ++a)
#pragma unroll
            for (int b = 0; b < 2; ++b)
#pragma unroll
                for (int m = 0; m < 4; ++m)
#pragma unroll
                    for (int n = 0; n < 2; ++n) acc[a][b][m][n] = (f32x4){0.f, 0.f, 0.f, 0.f};
        cur = nxt; cA = nA; cB = nB; ++ui;
        if constexpr (ALIGN_EPI) { if (wr == 1) PG8_BAR; }
    }
    PG8_WAIT_V(0);
    if constexpr (!ALIGN_EPI) { if (wr == 0) PG8_BAR; }
    PG8_BAR;
    if constexpr (Epi::AFTER_DRAIN) { E.fused(acc, cur, wr, wc, fr, fq, lds, wid, lane); S.done(cur); }
#undef PG8_SA
#undef PG8_SB
#undef PG8_STAGE
#undef PG8_LDA
#undef PG8_LDB
#undef PG8_MMA
#undef PG8_WAIT_V
#undef PG8_WAIT_L
#undef PG8_BAR
#undef PG8_SCHED
}
}

namespace att {
typedef unsigned short bf16;
constexpr int DQK = 96, DV = 64, NW = 8, QBLK = 32, KVBLK = 64, LDQ = 768, LDK = 768, LDV = 512, LDO = 1024;
constexpr float SCALE = 0.10206207261596577f;
constexpr size_t SHM_V = KVBLK * 128 * 2, SHM_K = KVBLK * 128 * 2, SHM_ATTN = 3 * SHM_V + 3 * SHM_K + NW * 64 * 4;
using bf16x8 = __attribute__((ext_vector_type(8))) short;
using s16x4  = __attribute__((ext_vector_type(4))) short;
using f32x16 = __attribute__((ext_vector_type(16))) float;
using u32x4  = __attribute__((ext_vector_type(4))) unsigned;
#define KSWZ(row, colB) ((row) * 256 + ((colB) ^ (((row) & 7) << 4)))
#define SBAR() __builtin_amdgcn_sched_barrier(0)
__device__ __forceinline__ int crow(int r, int hi) { return (r & 3) + 8 * (r >> 2) + 4 * hi; }
__device__ __forceinline__ unsigned cvtpk(float lo, float hi) { unsigned r; asm volatile("v_cvt_pk_bf16_f32 %0, %1, %2" : "=v"(r) : "v"(lo), "v"(hi)); return r; }
__device__ __forceinline__ bf16x8 ld8(const bf16* p) { return *reinterpret_cast<const bf16x8*>(p); }
__device__ __forceinline__ void partialSM(f32x16& p0) {
#pragma unroll
  for (int r = 0; r < 16; ++r) p0[r] = __builtin_amdgcn_exp2f(p0[r]);
}
__device__ __forceinline__ void finishSM(f32x16& p0, f32x16& p1, float& l_reg, bf16x8& pa0, bf16x8& pa1, bf16x8& pa2, bf16x8& pa3) {
#pragma unroll
  for (int r = 0; r < 16; ++r) p1[r] = __builtin_amdgcn_exp2f(p1[r]);
  float ps = 0;
#pragma unroll
  for (int r = 0; r < 16; ++r) ps += p0[r];
#pragma unroll
  for (int r = 0; r < 16; ++r) ps += p1[r];
  { auto rr = __builtin_amdgcn_permlane32_swap(__float_as_uint(ps), __float_as_uint(ps), false, false);
    ps = __uint_as_float(rr[0]) + __uint_as_float(rr[1]); }
  l_reg += ps;
#define PK4(P, BASE, OUT) do { unsigned a0 = cvtpk(P[BASE + 0], P[BASE + 1]), a1 = cvtpk(P[BASE + 2], P[BASE + 3]);   \
    unsigned b0 = cvtpk(P[BASE + 4], P[BASE + 5]), b1 = cvtpk(P[BASE + 6], P[BASE + 7]);                              \
    auto r0 = __builtin_amdgcn_permlane32_swap(a0, b0, false, false); auto r1 = __builtin_amdgcn_permlane32_swap(a1, b1, false, false); \
    u32x4 w = {r0[0], r1[0], r0[1], r1[1]}; OUT = *reinterpret_cast<bf16x8*>(&w); } while (0)
  PK4(p0, 0, pa0); PK4(p0, 8, pa1); PK4(p1, 0, pa2); PK4(p1, 8, pa3);
#undef PK4
}
__device__ __forceinline__ void qkt(f32x16& p0, f32x16& p1, const bf16* Ks, const bf16x8* qr, int r32, int hi, float negM) {
  p0 = f32x16{}; p1 = f32x16{};
#pragma unroll
  for (int d0 = 0; d0 < 6; ++d0) { int cb = (d0 * 16 + hi * 8) * 2;
    bf16x8 b0 = *reinterpret_cast<const bf16x8*>((const char*)Ks + KSWZ(r32, cb));
    bf16x8 b1 = *reinterpret_cast<const bf16x8*>((const char*)Ks + KSWZ(32 + r32, cb));
    p0 = __builtin_amdgcn_mfma_f32_32x32x16_bf16(b0, qr[d0], p0, 0, 0, 0);
    p1 = __builtin_amdgcn_mfma_f32_32x32x16_bf16(b1, qr[d0], p1, 0, 0, 0); }
  if (__builtin_expect(negM != 0.f, 0)) {
#pragma unroll
    for (int r = 0; r < 16; ++r) { p0[r] += negM; p1[r] += negM; } }
}
__device__ __forceinline__ int v_st(int k, int c) { const int kk = (k & ~0xC) | ((k & 4) << 1) | ((k & 8) >> 1); return ((kk >> 3) * 4 + (c >> 5)) * 512 + ((kk & 7) * 32 + (c & 31)) * 2; }
__device__ __forceinline__ int v_rd_base(int lane) { return ((lane & 3) << 3) | (((lane >> 2) & 3) << 6) | (((lane >> 4) & 1) << 5) | (((lane >> 5) & 1) << 8); }
constexpr int v_rd_off(int d0, int ks, int half) { return d0 * 512 + ks * 4096 + half * 2048; }
template <int OFF> __device__ __forceinline__ s16x4 tr_read(int vb) {
  s16x4 r; asm volatile("ds_read_b64_tr_b16 %0, %1 offset:%2" : "=&v"(r) : "v"(vb), "i"(OFF) : "memory"); return r;
}
template <int D0> __device__ __forceinline__ void pv_one(f32x16& od, int vb, bf16x8 pa0, bf16x8 pa1, bf16x8 pa2, bf16x8 pa3) {
  const s16x4 l0 = tr_read<v_rd_off(D0, 0, 0)>(vb), h0 = tr_read<v_rd_off(D0, 0, 1)>(vb), l1 = tr_read<v_rd_off(D0, 1, 0)>(vb), h1 = tr_read<v_rd_off(D0, 1, 1)>(vb);
  const s16x4 l2 = tr_read<v_rd_off(D0, 2, 0)>(vb), h2 = tr_read<v_rd_off(D0, 2, 1)>(vb), l3 = tr_read<v_rd_off(D0, 3, 0)>(vb), h3 = tr_read<v_rd_off(D0, 3, 1)>(vb);
  asm volatile("s_waitcnt lgkmcnt(0)" ::: "memory"); SBAR();
#define PK(L, H) (bf16x8){L[0], L[1], L[2], L[3], H[0], H[1], H[2], H[3]}
  od = __builtin_amdgcn_mfma_f32_32x32x16_bf16(pa0, PK(l0, h0), od, 0, 0, 0);
  od = __builtin_amdgcn_mfma_f32_32x32x16_bf16(pa1, PK(l1, h1), od, 0, 0, 0);
  od = __builtin_amdgcn_mfma_f32_32x32x16_bf16(pa2, PK(l2, h2), od, 0, 0, 0);
  od = __builtin_amdgcn_mfma_f32_32x32x16_bf16(pa3, PK(l3, h3), od, 0, 0, 0);
#undef PK
}
__device__ __forceinline__ void pv_d0(f32x16* o, int vb, bf16x8 pa0, bf16x8 pa1, bf16x8 pa2, bf16x8 pa3) {
  pv_one<0>(o[0], vb, pa0, pa1, pa2, pa3); pv_one<1>(o[1], vb, pa0, pa1, pa2, pa3);
}
__device__ __forceinline__ void attn_body(const bf16* __restrict__ Qb, const bf16* __restrict__ Kh, const bf16* __restrict__ Vh, bf16* __restrict__ Ob, int seq, char* lds, float negM) {
  int tid_l = threadIdx.x; asm volatile("" : "+v"(tid_l));
  const int tid = tid_l, wid = tid >> 6, lane = tid & 63, r32 = lane & 31, hi = lane >> 5;
  static_assert(SHM_V == SHM_K, "one byte offset addresses both rings");
  bf16* V_lds = (bf16*)lds; bf16* K_lds = (bf16*)(lds + 3 * SHM_V);
  float* ws = (float*)(lds + 3 * SHM_V + 3 * SHM_K) + wid * 64; float* li_l = ws;
  float l_reg = 0; f32x16 o[2] = {}; bf16x8 qr[6];
  const bf16* Qw = Qb + (long)(wid * QBLK + r32) * LDQ + hi * 8;
#pragma unroll
  for (int d0 = 0; d0 < 6; ++d0) qr[d0] = ld8(Qw + d0 * 16);
  const int sr = tid >> 4, sc = (tid & 15) * 8, vst0 = v_st(sr, sc), vst1 = v_st(32 + sr, sc);
  const int kcol = sc < 96 ? sc : 88, vcol = sc < 64 ? sc : 56;
  const int vb0 = (int)(uintptr_t)V_lds + v_rd_base(lane);
  struct { bf16x8 vs0, vs1, ks0, ks1; } sr_[2];
#define SLOAD(i, k0) do { sr_[i].vs0 = ld8(&Vh[(long)((k0) + sr) * LDV + vcol]); sr_[i].vs1 = ld8(&Vh[(long)((k0) + 32 + sr) * LDV + vcol]); \
    sr_[i].ks0 = ld8(&Kh[(long)((k0) + sr) * LDK + kcol]); sr_[i].ks1 = ld8(&Kh[(long)((k0) + 32 + sr) * LDK + kcol]); } while (0)
#define SWRITE(boff, i) do { if (sc < 64) { *(bf16x8*)((char*)V_lds + (boff) + vst0) = sr_[i].vs0;          \
    *(bf16x8*)((char*)V_lds + (boff) + vst1) = sr_[i].vs1; } int kc = sc * 2;               \
    if (sc < 96) { *(bf16x8*)((char*)K_lds + (boff) + KSWZ(sr, kc)) = sr_[i].ks0;                       \
    *(bf16x8*)((char*)K_lds + (boff) + KSWZ(32 + sr, kc)) = sr_[i].ks1; } } while (0)
  f32x16 pA0, pA1, pB0, pB1; bf16x8 pa0, pa1, pa2, pa3; const int NT = seq / KVBLK;
  if (__builtin_amdgcn_readfirstlane(tid) >= 256) __builtin_amdgcn_s_setprio(1);
  SLOAD(0, 0); SLOAD(1, KVBLK);
  SWRITE(0, 0); __syncthreads();
  SWRITE((int)SHM_V, 1);
  qkt(pA0, pA1, K_lds, qr, r32, hi, negM); partialSM(pA0);
  if (2 < NT) SLOAD(0, 2 * KVBLK);
  __syncthreads();
  int o_prev = 0, o_cur = (int)SHM_V, o_next = 2 * (int)SHM_V;
#define ASTEP(PC0, PC1, PP0, PP1, WSLOT, LSLOT, LCOND, LTILE) do { \
    SWRITE(o_next, WSLOT); \
    SBAR(); qkt(PC0, PC1, (bf16*)((char*)K_lds + o_cur), qr, r32, hi, negM); \
    finishSM(PP0, PP1, l_reg, pa0, pa1, pa2, pa3); SBAR(); \
    if (LCOND) SLOAD(LSLOT, (LTILE) * KVBLK); SBAR(); \
    pv_d0(o, vb0 + o_prev, pa0, pa1, pa2, pa3); partialSM(PC0); \
    __syncthreads(); \
    { const int t_ = o_prev; o_prev = o_cur; o_cur = o_next; o_next = t_; } } while (0)
  for (int j = 1; j + 1 < NT; j += 2) {
    ASTEP(pB0, pB1, pA0, pA1, 0, 1, true, j + 2);
    ASTEP(pA0, pA1, pB0, pB1, 1, 0, j + 3 < NT, j + 3);
  }
#undef ASTEP
  SBAR(); qkt(pB0, pB1, (bf16*)((char*)K_lds + o_cur), qr, r32, hi, negM);
  finishSM(pA0, pA1, l_reg, pa0, pa1, pa2, pa3); SBAR();
  pv_d0(o, vb0 + o_prev, pa0, pa1, pa2, pa3); partialSM(pB0);
  finishSM(pB0, pB1, l_reg, pa0, pa1, pa2, pa3); SBAR();
  pv_d0(o, vb0 + o_cur, pa0, pa1, pa2, pa3);
  __builtin_amdgcn_s_setprio(0);
  if (hi == 0) li_l[r32] = l_reg; asm volatile("s_waitcnt lgkmcnt(0)" ::: "memory");
  float rli[16];
#pragma unroll
  for (int r = 0; r < 16; ++r) rli[r] = __builtin_amdgcn_rcpf(li_l[crow(r, hi)]);
  bf16* Ow = Ob + (long)(wid * QBLK) * LDO;
#pragma unroll
  for (int r = 0; r < 16; ++r) { int orow = crow(r, hi);
#pragma unroll
    for (int d0 = 0; d0 < 2; ++d0) { const float v = o[d0][r] * rli[r]; unsigned u = __float_as_uint(v); u = (u + 0x7fffu + ((u >> 16) & 1u)) >> 16; Ow[(long)orow * LDO + d0 * 32 + r32] = (bf16)u; } }
  __syncthreads();
#undef SLOAD
#undef SWRITE
}
#undef KSWZ
#undef SBAR
}

typedef unsigned short bf16;
#define LAS __attribute__((address_space(3)))
typedef float f32x4 __attribute__((ext_vector_type(4)));
typedef unsigned v4u __attribute__((ext_vector_type(4)));
typedef unsigned v2u __attribute__((ext_vector_type(2)));
constexpr int TL = 32768, TC = 1024, TT = TL + TC, DM = 1024, FF = 2816, NINP = 2304, LAT = 8192, CTXL = 256, KVS = LAT + CTXL, DEPTH = 4;
constexpr int PC_Q = 0, PC_FF = 256, PC_FB = 512, PC_I = 768, PC_G = 1024, PC_CQ = 1280, PC_CKV = 1664, PC_KPE = 1920, PC_POOL = 1952;
constexpr float EPS = 1e-6f;
constexpr int NCHUNK = 128, NCHAIN = 32, CHL = 66, SUBN = 11, NSUB = 6;
constexpr size_t MiB = 1u << 20;
constexpr size_t WS_BAR = 800 * 1024, WS_BAR_BYTES = 16384;
constexpr size_t WS_MOD = 0, WS_LB = 768 * 1024, WS_XC = 1 * MiB, WS_W = 5 * MiB, WS_XN = 46 * MiB, WS_BIG = 112 * MiB, WS_V = WS_BIG + 149 * MiB,
                 WS_R1 = 294 * MiB, WS_CKVN = WS_R1 + 25 * MiB, WS_Q = 336 * MiB, WS_KVRAW = 386 * MiB, WS_K = 452 * MiB, WS_U = 502 * MiB, WS_PC = 568 * MiB, WS_END = 570 * MiB;
constexpr size_t W_F1IN = 0, W_F1OUT = 11534336, W_F2IN = 17301504, W_F2OUT = 28835840, W_IN = 34603008, W_OUT = 39321600, W_UQ = 41418752, W_UKV = 42008576;
constexpr size_t WS_ATTM = WS_LB + 16384;
constexpr size_t WS_HGF = WS_PC + 1 * MiB;
constexpr int LDS_BYTES = 147456;
constexpr int NPH_LAYER = 13, NPHASES = 1 + DEPTH * NPH_LAYER;

struct Args { const float* in[22]; float* out; unsigned char* ws; int ph_lo, ph_hi; };
#define AIN(i) argin(a, i)


__device__ __forceinline__ const float* argin(const Args& a, int i) { asm volatile("" : "+s"(i)); return a.in[i]; }
__device__ __forceinline__ float bf2f(unsigned h) { return __uint_as_float(h << 16); }
__device__ __forceinline__ unsigned f2bf(float f) { unsigned u = __float_as_uint(f); return (u + 0x7fffu + ((u >> 16) & 1u)) >> 16; }
__device__ __forceinline__ unsigned pk2(float lo, float hi) { return f2bf(lo) | (f2bf(hi) << 16); }
__device__ __forceinline__ float wave_sum(float v) {
#pragma unroll
    for (int o = 1; o < 64; o <<= 1) v += __shfl_xor(v, o);
    return v;
}
__device__ __forceinline__ float sigm(float z) { return __builtin_amdgcn_rcpf(1.0f + __builtin_amdgcn_exp2f(-1.4426950408889634f * z)); }
#define LDS_WAIT() asm volatile("s_waitcnt lgkmcnt(0)" ::: "memory")

__device__ __forceinline__ void transpose_item(const float* W, int K, int Nsrc, bf16* WT, int k0, int dst0, int src0, LAS float* scr, int lane) {
    if (src0 >= 0) {
        float tmp[32];
#pragma unroll
        for (int i = 0; i < 32; ++i) { const int kk = 2 * i + (lane >> 5); tmp[i] = W[(size_t)(k0 + kk) * Nsrc + src0 + (lane & 31)]; }
        __builtin_amdgcn_sched_barrier(0);
#pragma unroll
        for (int i = 0; i < 32; ++i) { const int kk = 2 * i + (lane >> 5); scr[kk * 33 + (lane & 31)] = tmp[i]; }
    }
    LDS_WAIT(); asm volatile("" ::: "memory");
    const int c = lane & 7;
#pragma unroll
    for (int j = 0; j < 4; ++j) { const int n = (lane >> 3) + 8 * j; const LAS float* s = scr + (8 * c) * 33 + n;
        v4u o;
        if (src0 >= 0) { o.x = pk2(s[0 * 33], s[1 * 33]); o.y = pk2(s[2 * 33], s[3 * 33]); o.z = pk2(s[4 * 33], s[5 * 33]); o.w = pk2(s[6 * 33], s[7 * 33]); }
        else { unsigned z = 0u; asm volatile("" : "+v"(z)); o.x = z; o.y = z; o.z = z; o.w = z; }
        *(v4u*)(WT + (size_t)(dst0 + n) * K + k0 + 8 * c) = o; }
    LDS_WAIT(); asm volatile("" ::: "memory");
}
__device__ __forceinline__ void modnorm_row(const float* xrow, const float* shift, const float* scale, bf16* orow, int lane) {
    const f32x4* xr = (const f32x4*)xrow + lane; const f32x4* sh = (const f32x4*)shift + lane; const f32x4* sc = (const f32x4*)scale + lane;
    f32x4 v[4]; float s = 0.f;
#pragma unroll
    for (int j = 0; j < 4; ++j) { v[j] = xr[64 * j]; s += (v[j].x * v[j].x + v[j].y * v[j].y) + (v[j].z * v[j].z + v[j].w * v[j].w); }
    const float rstd = 1.0f / sqrtf(wave_sum(s) * (1.f / 1024.f) + EPS);
    v2u* o8 = (v2u*)orow + lane;
#pragma unroll
    for (int j = 0; j < 4; ++j) { const f32x4 a = sc[64 * j], b = sh[64 * j]; const f32x4 y = v[j] * rstd * (a + 1.0f) + b;
        v2u w; w.x = pk2(y.x, y.y); w.y = pk2(y.z, y.w); o8[64 * j] = w; }
}
__device__ __forceinline__ const float* xrow_ptr(const float* xl, const float* xc, int r) { return r < TL ? xl + (size_t)r * DM : xc + (size_t)(r - TL) * DM; }

__device__ __forceinline__ void phase_init(const Args& a, LAS unsigned char* lds, int tid, int wave, int lane) {
    const float* c = AIN(1); const float* c_ctx = AIN(3); const float* w_mod = AIN(4); const float* b_mod = AIN(5);
    float* mod = (float*)(a.ws + WS_MOD);
    LAS float* AL = (LAS float*)lds; LAS float* RL = (LAS float*)(lds + 20480);
    for (int i = tid; i < 5 * 1024; i += 512) { const int s = i >> 10, k = i & 1023; const float v = s < 4 ? c[s * 1024 + k] : c_ctx[k]; AL[i] = v * sigm(v); }
    __syncthreads();
    for (int item = blockIdx.x; item < 4 * 144; item += gridDim.x) {
        const int l = item / 144, n0 = (item % 144) * 64;
        const float* W = w_mod + (size_t)l * 1024 * 9216 + n0 + lane;
        float acc0 = 0.f, acc1 = 0.f, acc2 = 0.f, acc3 = 0.f, acc4 = 0.f; const int k0 = wave * 128;
        for (int kb = 0; kb < 128; kb += 32) { float w[32];
#pragma unroll
            for (int kk = 0; kk < 32; ++kk) w[kk] = W[(size_t)(k0 + kb + kk) * 9216];
            __builtin_amdgcn_sched_barrier(0);
#pragma unroll
            for (int kk = 0; kk < 32; ++kk) { const int k = k0 + kb + kk;
                acc0 += AL[k] * w[kk]; acc1 += AL[1024 + k] * w[kk]; acc2 += AL[2048 + k] * w[kk]; acc3 += AL[3072 + k] * w[kk]; acc4 += AL[4096 + k] * w[kk]; } }
        RL[(wave * 5 + 0) * 64 + lane] = acc0; RL[(wave * 5 + 1) * 64 + lane] = acc1; RL[(wave * 5 + 2) * 64 + lane] = acc2; RL[(wave * 5 + 3) * 64 + lane] = acc3; RL[(wave * 5 + 4) * 64 + lane] = acc4;
        __syncthreads();
        if (tid < 320) { const int s = tid >> 6; float sum = b_mod[l * 9216 + n0 + lane];
#pragma unroll
            for (int w = 0; w < 8; ++w) sum += RL[(w * 5 + s) * 64 + lane];
            mod[(size_t)(l * 5 + s) * 9216 + n0 + lane] = sum; }
        __syncthreads();
    }
    if (blockIdx.x == 0) {
        const float* lg = AIN(10); float* LB = (float*)(a.ws + WS_LB);
        const float z0 = lg[tid], z1 = lg[512 + tid], z2 = lg[1024 + tid], z3 = lg[1536 + tid];
        const float mx = fmaxf(fmaxf(z0, z1), fmaxf(z2, z3));
        const float e0 = __expf(z0 - mx), e1 = __expf(z1 - mx), e2 = __expf(z2 - mx), e3 = __expf(z3 - mx); const float inv = 1.0f / (e0 + e1 + e2 + e3);
        LB[tid] = 0.f; LB[512 + tid] = e1 * inv; LB[1024 + tid] = (e1 + e2) * inv; LB[1536 + tid] = (e1 + e2 + e3) * inv;
    }
}

__device__ __forceinline__ void phase_wconv(const Args& a, LAS unsigned char* lds, int l, int wave, int lane) {
    LAS float* scr = (LAS float*)(lds + wave * 8448);
    unsigned char* wb = a.ws + WS_W;
    const int gw = blockIdx.x * 8 + wave, NGW = gridDim.x * 8;
    constexpr int I1 = 16 * 176, I2 = 44 * 32, I5 = 16 * 72, I6 = 16 * 32, I7 = 6 * 24, I8 = 4 * 32, NIT = 2 * (I1 + I2) + I5 + I6 + I7 + I8;
    for (int it = gw; it < NIT; it += NGW) {
        int r = it;
        if (r < 2 * I1) { const int f = r / I1; r -= f * I1; const int kb = r / 176, nb = r % 176, n0 = nb * 32; const int src = ((n0 >> 7) & 1) * FF + (n0 >> 8) * 128 + (n0 & 127);
            transpose_item(AIN(f ? 20 : 6) + (size_t)l * 1024 * 5632, 1024, 5632, (bf16*)(wb + (f ? W_F2IN : W_F1IN)), kb * 64, n0, src, scr, lane); continue; }
        r -= 2 * I1;
        if (r < 2 * I2) { const int f = r / I2; r -= f * I2; const int kb = r / 32, nb = r % 32;
            transpose_item(AIN(f ? 21 : 7) + (size_t)l * FF * 1024, FF, 1024, (bf16*)(wb + (f ? W_F2OUT : W_F1OUT)), kb * 64, nb * 32, nb * 32, scr, lane); continue; }
        r -= 2 * I2;
        if (r < I5) { const int kb = r / 72, nb = r % 72; transpose_item(AIN(8) + (size_t)l * 1024 * 2208, 1024, 2208, (bf16*)(wb + W_IN), kb * 64, nb * 32, nb < 69 ? nb * 32 : -1, scr, lane); continue; }
        r -= I5;
        if (r < I6) { const int kb = r / 32, nb = r % 32; transpose_item(AIN(9) + (size_t)l * 1024 * 1024, 1024, 1024, (bf16*)(wb + W_OUT), kb * 64, nb * 32, nb * 32, scr, lane); continue; }
        r -= I6;
        if (r < I7) { const int kb = r / 24, nb = r % 24; transpose_item(AIN(13) + (size_t)l * 384 * 768, 384, 768, (bf16*)(wb + W_UQ), kb * 64, nb * 32, nb * 32, scr, lane); continue; }
        r -= I7;
        { const int kb = r / 32, nb = r % 32; transpose_item(AIN(15) + (size_t)l * 256 * 1024, 256, 1024, (bf16*)(wb + W_UKV), kb * 64, nb * 32, nb * 32, scr, lane); }
    }
}
__device__ __forceinline__ void phase_norm(const Args& a, int l, int j0, const float* xl, const float* xc, int nrows, int wave, int lane) {
    const float* mod = (const float*)(a.ws + WS_MOD) + (size_t)l * 5 * 9216; bf16* XN = (bf16*)(a.ws + WS_XN);
    const int gw = blockIdx.x * 8 + wave, NGW = gridDim.x * 8;
    for (int r0 = gw * 4; r0 < nrows; r0 += NGW * 4) {
        const int s = r0 < TL ? (r0 >> 13) : 4; const float* m = mod + (size_t)s * 9216 + j0 * 1024;
        const f32x4* sh = (const f32x4*)m + lane; const f32x4* sc = (const f32x4*)(m + 1024) + lane;
        f32x4 v[4][4];
#pragma unroll
        for (int q = 0; q < 4; ++q) { const f32x4* xr = (const f32x4*)xrow_ptr(xl, xc, r0 + q) + lane;
#pragma unroll
            for (int j = 0; j < 4; ++j) v[q][j] = xr[64 * j]; }
        f32x4 av[4], bv[4];
#pragma unroll
        for (int j = 0; j < 4; ++j) { av[j] = sc[64 * j] + 1.0f; bv[j] = sh[64 * j]; }
        __builtin_amdgcn_sched_barrier(0);
#pragma unroll
        for (int q = 0; q < 4; ++q) { float ss = 0.f;
#pragma unroll
            for (int j = 0; j < 4; ++j) ss += (v[q][j].x * v[q][j].x + v[q][j].y * v[q][j].y) + (v[q][j].z * v[q][j].z + v[q][j].w * v[q][j].w);
            const float rstd = 1.0f / sqrtf(wave_sum(ss) * (1.f / 1024.f) + EPS);
            v2u* o8 = (v2u*)(XN + (size_t)(r0 + q) * DM) + lane;
#pragma unroll
            for (int j = 0; j < 4; ++j) { const f32x4 y = v[q][j] * rstd * av[j] + bv[j]; v2u w; w.x = pk2(y.x, y.y); w.y = pk2(y.z, y.w); o8[64 * j] = w; } }
    }
}
__device__ __forceinline__ void phase_mla_norm(const Args& a, int l, int wave, int lane) {
    const bf16* P = (const bf16*)(a.ws + WS_BIG); bf16* CQN = (bf16*)(a.ws + WS_R1); bf16* CKVN = (bf16*)(a.ws + WS_CKVN);
    const float* qg = AIN(12) + l * 384; const float* kg = AIN(14) + l * 256;
    const int gw = blockIdx.x * 8 + wave, NGW = gridDim.x * 8;
    float gq[6], gk[4];
#pragma unroll
    for (int j = 0; j < 3; ++j) { gq[2 * j] = qg[128 * j + 2 * lane]; gq[2 * j + 1] = qg[128 * j + 2 * lane + 1]; }
#pragma unroll
    for (int j = 0; j < 4; ++j) gk[j] = kg[4 * lane + j];
    for (int r0 = gw * 4; r0 < TT; r0 += NGW * 4) {
        unsigned wq[4][3]; v2u wk[4];
#pragma unroll
        for (int q = 0; q < 4; ++q) { const bf16* pr = P + (size_t)(r0 + q) * NINP;
#pragma unroll
            for (int j = 0; j < 3; ++j) wq[q][j] = *(const unsigned*)(pr + PC_CQ + 128 * j + 2 * lane);
            wk[q] = *(const v2u*)(pr + PC_CKV + 4 * lane); }
        __builtin_amdgcn_sched_barrier(0);
#pragma unroll
        for (int q = 0; q < 4; ++q) { const int r = r0 + q; float x[6]; float s = 0.f;
#pragma unroll
            for (int j = 0; j < 3; ++j) { x[2 * j] = bf2f(wq[q][j] & 0xffffu); x[2 * j + 1] = bf2f(wq[q][j] >> 16); s += x[2 * j] * x[2 * j] + x[2 * j + 1] * x[2 * j + 1]; }
            const float rq = 1.0f / sqrtf(wave_sum(s) * (1.f / 384.f) + EPS);
#pragma unroll
            for (int j = 0; j < 3; ++j) *(unsigned*)(CQN + (size_t)r * 384 + 128 * j + 2 * lane) = pk2(x[2 * j] * rq * gq[2 * j], x[2 * j + 1] * rq * gq[2 * j + 1]);
            const float y0 = bf2f(wk[q].x & 0xffffu), y1 = bf2f(wk[q].x >> 16), y2 = bf2f(wk[q].y & 0xffffu), y3 = bf2f(wk[q].y >> 16);
            const float rk = 1.0f / sqrtf(wave_sum(y0 * y0 + y1 * y1 + y2 * y2 + y3 * y3) * (1.f / 256.f) + EPS);
            v2u o; o.x = pk2(y0 * rk * gk[0], y1 * rk * gk[1]); o.y = pk2(y2 * rk * gk[2], y3 * rk * gk[3]);
            *(v2u*)(CKVN + (size_t)r * 256 + 4 * lane) = o; }
    }
}

__device__ __forceinline__ int hgrn_row(int b, int dir, int p) {
    if (dir == 0) return p < CTXL ? TL + b * CTXL + p : b * LAT + (p - CTXL);
    return p < CTXL ? TL + b * CTXL + (CTXL - 1 - p) : b * LAT + (LAT - 1) - (p - CTXL);
}
__device__ __forceinline__ void hgrn_out_seq(const Args& a, int l, int ch, int j, int lane_in) {
    int lane = lane_in; asm volatile("" : "+v"(lane));
    const bf16* P = (const bf16*)(a.ws + WS_BIG); const float* U = (const float*)(a.ws + WS_U); float* OF = (float*)(a.ws + WS_R1); bf16* MIX = (bf16*)(a.ws + WS_XN);
    const int dir = ch & 1, bh = ch >> 1, b = bh >> 2, h = bh & 3, task = ch * NCHUNK + j, p0 = j * CHL;
    const float lbv = ((const float*)(a.ws + WS_LB))[l * 512 + dir * 256 + h * 64 + lane];
    const int fcol = dir ? PC_FB : PC_FF; const float gain = AIN(11)[l * 64 + lane];
    float S[64];
#pragma unroll
    for (int k = 0; k < 64; ++k) S[k] = U[(size_t)task * 4096 + k * 64 + lane];
    for (int t = 0; t < CHL; ++t) {
        const int r = hgrn_row(b, dir, p0 + t); const bf16* pr = P + (size_t)r * NINP + h * 64 + lane;
        const float f = lbv + (1.0f - lbv) * sigm(bf2f(pr[fcol])); const float fc = fminf(fmaxf(f, 1e-6f), 1.0f), kk = 1.0f - f;
        const float qz = bf2f(pr[PC_Q]); const float qv = qz * sigm(qz), iz = bf2f(pr[PC_I]);
        float o = 0.f;
#pragma unroll
        for (int k = 0; k < 64; ++k) { const float fk = __shfl(fc, k), kx = __shfl(kk, k), qk = __shfl(qv, k); S[k] = fmaf(S[k], fk, kx * iz); o = fmaf(S[k], qk, o); }
        if (dir == 0) OF[(size_t)r * 256 + h * 64 + lane] = o;
        else { const float ot = o + OF[(size_t)r * 256 + h * 64 + lane]; const float rs = 1.0f / sqrtf(wave_sum(ot * ot) * (1.f / 64.f) + EPS); const float gz = bf2f(pr[PC_G]);
            MIX[(size_t)r * DM + h * 64 + lane] = (bf16)f2bf(ot * rs * gain * (gz * sigm(gz))); }
    }
}
__device__ __forceinline__ void hgrn_state_mfma(const Args& a, LAS unsigned char* wl, int l, int ch, int j, int lane) {
    typedef short bf16x8_t __attribute__((ext_vector_type(8)));
    const bf16* P = (const bf16*)(a.ws + WS_BIG); float* U = (float*)(a.ws + WS_U); float* PCp = (float*)(a.ws + WS_PC);
    const int dir = ch & 1, bh = ch >> 1, b = bh >> 2, h = bh & 3, task = ch * NCHUNK + j, p0 = j * CHL;
    const float lbv = ((const float*)(a.ws + WS_LB))[l * 512 + dir * 256 + h * 64 + lane];
    const int fcol = dir ? PC_FB : PC_FF;
    LAS unsigned short* KT = (LAS unsigned short*)wl; LAS unsigned short* VT = KT + 64 * 40;
    f32x4 acc[4][4];
#pragma unroll
    for (int i = 0; i < 4; ++i)
#pragma unroll
        for (int jj = 0; jj < 4; ++jj) acc[i][jj] = (f32x4){0.f, 0.f, 0.f, 0.f};
    float D = 1.0f; bool bad = false;
#pragma unroll
    for (int blk = 2; blk >= 0; --blk) {
        const int nval = (blk == 2) ? 2 : 32, s_lo = blk * 32; const float Dblk0 = D;
        for (int hf = 1; hf >= 0; --hf) {
            unsigned short rf[16], ri[16];
#pragma unroll
            for (int s1 = 0; s1 < 16; ++s1) { const int ss = 16 * hf + s1; const int r = hgrn_row(b, dir, p0 + s_lo + (ss < nval ? ss : 0)); const bf16* pr = P + (size_t)r * NINP + h * 64 + lane; rf[s1] = pr[fcol]; ri[s1] = pr[PC_I]; }
            __builtin_amdgcn_sched_barrier(0);
#pragma unroll
            for (int s1 = 15; s1 >= 0; --s1) { const int ss = 16 * hf + s1;
                if (ss < nval) { const float f = lbv + (1.0f - lbv) * sigm(bf2f(rf[s1])); const float fc = fminf(fmaxf(f, 1e-6f), 1.0f);
                    KT[lane * 40 + ss] = (unsigned short)f2bf((1.0f - f) * D); VT[lane * 40 + ss] = ri[s1]; D *= fc; }
                else { KT[lane * 40 + ss] = 0; VT[lane * 40 + ss] = 0; }
            }
        }
        bad |= !(D > 1e-30f * Dblk0);
        LDS_WAIT(); asm volatile("" ::: "memory");
        bf16x8_t af[4], bfr[4];
#pragma unroll
        for (int i = 0; i < 4; ++i) { af[i] = *(const LAS bf16x8_t*)(KT + (16 * i + (lane & 15)) * 40 + 8 * (lane >> 4)); bfr[i] = *(const LAS bf16x8_t*)(VT + (16 * i + (lane & 15)) * 40 + 8 * (lane >> 4)); }
#pragma unroll
        for (int i = 0; i < 4; ++i)
#pragma unroll
            for (int jj = 0; jj < 4; ++jj) acc[i][jj] = __builtin_amdgcn_mfma_f32_16x16x32_bf16(af[i], bfr[jj], acc[i][jj], 0, 0, 0);
        LDS_WAIT(); asm volatile("" ::: "memory");
    }
    float* up = U + (size_t)task * 4096;
#pragma unroll
    for (int i = 0; i < 4; ++i)
#pragma unroll
        for (int jj = 0; jj < 4; ++jj)
#pragma unroll
            for (int rg = 0; rg < 4; ++rg) up[(16 * i + 4 * (lane >> 4) + rg) * 64 + 16 * jj + (lane & 15)] = acc[i][jj][rg];
    PCp[task * 64 + lane] = D;
    if (lane == 0) ((int*)(a.ws + WS_HGF))[task] = 0;
    if (__any(bad)) { if (lane == 0) ((int*)(a.ws + WS_HGF))[task] = 1; }
}

namespace hgm {
using bf16x8 = __attribute__((ext_vector_type(8))) short;
using s16x4  = __attribute__((ext_vector_type(4))) short;
using f32x16 = __attribute__((ext_vector_type(16))) float;
__device__ __forceinline__ int crow(int r, int hi) { return (r & 3) + 8 * (r >> 2) + 4 * hi; }
__device__ __forceinline__ unsigned cvtpk(float lo, float hi) { unsigned r; asm volatile("v_cvt_pk_bf16_f32 %0, %1, %2" : "=v"(r) : "v"(lo), "v"(hi)); return r; }
__device__ __forceinline__ int v_st2(int k, int c) { const int kk = (k & ~0xC) | ((k & 4) << 1) | ((k & 8) >> 1); return ((kk >> 3) * 2 + (c >> 5)) * 512 + ((kk & 7) * 32 + (c & 31)) * 2; }
__device__ __forceinline__ int v_rd_base(int lane) { return ((lane & 3) << 3) | (((lane >> 2) & 3) << 6) | (((lane >> 4) & 1) << 5) | (((lane >> 5) & 1) << 8); }
constexpr int v_rd_off2(int d0, int ks, int half) { return ((2 * ks + half) * 2 + d0) * 512; }
template <int OFF> __device__ __forceinline__ s16x4 tr_read(int vb) { s16x4 r; asm volatile("ds_read_b64_tr_b16 %0, %1 offset:%2" : "=&v"(r) : "v"(vb), "i"(OFF) : "memory"); return r; }
}
__device__ __forceinline__ void hgrn_out_mfma(const Args& a, LAS unsigned char* wl, int l, int ch, int j, int lane_in) {
    using namespace hgm;
    int lane = lane_in; asm volatile("" : "+v"(lane));
    const bf16* P = (const bf16*)(a.ws + WS_BIG); const float* U = (const float*)(a.ws + WS_U); float* OF = (float*)(a.ws + WS_R1); bf16* MIX = (bf16*)(a.ws + WS_XN);
    const int dir = ch & 1, bh = ch >> 1, b = bh >> 2, h = bh & 3, task = ch * NCHUNK + j, p0 = j * CHL, r32 = lane & 31, hi = lane >> 5;
    const float lbv = ((const float*)(a.ws + WS_LB))[l * 512 + dir * 256 + h * 64 + lane];
    const int fcol = dir ? PC_FB : PC_FF;
    constexpr int QOFF = 0, KOFF = 5120, VOFF = 10240, EOFF = 14336, QP = 144, KBP = 80;
    const int vb = (int)(uintptr_t)(unsigned char*)(wl + VOFF) + v_rd_base(lane);
    const float g0 = AIN(11)[l * 64 + r32], g1 = AIN(11)[l * 64 + 32 + r32];
    f32x16 S[2][2];
#pragma unroll
    for (int kb = 0; kb < 2; ++kb)
#pragma unroll
        for (int d = 0; d < 2; ++d)
#pragma unroll
            for (int r = 0; r < 16; ++r) S[kb][d][r] = U[(size_t)task * 4096 + (32 * kb + crow(r, hi)) * 64 + 32 * d + r32];
    for (int blk = 0; blk < 3; ++blk) {
        const int nval = (blk == 2) ? CHL - 64 : 32, pb = p0 + 32 * blk;
        bf16x8 vch[4];
#pragma unroll
        for (int i = 0; i < 4; ++i) { const int c = lane + 64 * i, sidx = c >> 3, vc = (c & 7) * 8; const int r = hgrn_row(b, dir, pb + (sidx < nval ? sidx : 0));
            vch[i] = *(const bf16x8*)(P + (size_t)r * NINP + PC_I + h * 64 + vc); if (sidx >= nval) vch[i] = (bf16x8){0, 0, 0, 0, 0, 0, 0, 0}; }
        __builtin_amdgcn_sched_barrier(0);
#pragma unroll
        for (int i = 0; i < 4; ++i) { const int c = lane + 64 * i, sidx = c >> 3, vc = (c & 7) * 8; *(LAS bf16x8*)(wl + VOFF + v_st2(sidx, vc)) = vch[i]; }
        float e = 1.0f;
        for (int hf = 0; hf < 2; ++hf) {
            unsigned short rf[16], rq[16];
#pragma unroll
            for (int s1 = 0; s1 < 16; ++s1) { const int ss = 16 * hf + s1; const int r = hgrn_row(b, dir, pb + (ss < nval ? ss : 0)); const bf16* pr = P + (size_t)r * NINP + h * 64 + lane; rf[s1] = pr[fcol]; rq[s1] = pr[PC_Q]; }
            __builtin_amdgcn_sched_barrier(0);
#pragma unroll
            for (int s1 = 0; s1 < 16; ++s1) { const int ss = 16 * hf + s1;
                unsigned qb = 0u, kbits = 0u;
                if (ss < nval) { const float f = lbv + (1.0f - lbv) * sigm(bf2f(rf[s1])); const float fc = fminf(fmaxf(f, 1e-6f), 1.0f); e *= fc;
                    const float qz = bf2f(rq[s1]); qb = f2bf(qz * sigm(qz) * e); kbits = f2bf((1.0f - f) * __builtin_amdgcn_rcpf(fmaxf(e, 1e-35f))); }
                *(LAS unsigned short*)(wl + QOFF + ss * QP + 2 * lane) = (unsigned short)qb; *(LAS unsigned short*)(wl + KOFF + ss * QP + 2 * lane) = (unsigned short)kbits;
            }
        }
        LDS_WAIT(); asm volatile("" ::: "memory");
        f32x16 p = {};
#pragma unroll
        for (int ks = 0; ks < 4; ++ks) { const bf16x8 af = *(const LAS bf16x8*)(wl + KOFF + r32 * QP + (16 * ks + 8 * hi) * 2), bq = *(const LAS bf16x8*)(wl + QOFF + r32 * QP + (16 * ks + 8 * hi) * 2);
            p = __builtin_amdgcn_mfma_f32_32x32x16_bf16(af, bq, p, 0, 0, 0); }
#pragma unroll
        for (int r = 0; r < 16; ++r) if (crow(r, hi) > r32) p[r] = 0.f;
        bf16x8 pa0, pa1;
#define HG_PK4(PP, BASE, OUT) do { unsigned a0 = cvtpk(PP[BASE + 0], PP[BASE + 1]), a1 = cvtpk(PP[BASE + 2], PP[BASE + 3]); unsigned b0 = cvtpk(PP[BASE + 4], PP[BASE + 5]), b1 = cvtpk(PP[BASE + 6], PP[BASE + 7]); \
    auto q0 = __builtin_amdgcn_permlane32_swap(a0, b0, false, false); auto q1 = __builtin_amdgcn_permlane32_swap(a1, b1, false, false); v4u w = {q0[0], q1[0], q0[1], q1[1]}; OUT = *reinterpret_cast<bf16x8*>(&w); } while (0)
        HG_PK4(p, 0, pa0); HG_PK4(p, 8, pa1);
#undef HG_PK4
#define HG_PK(L_, H_) (bf16x8){L_[0], L_[1], L_[2], L_[3], H_[0], H_[1], H_[2], H_[3]}
#define HG_VFRAGS() do { const s16x4 l00 = tr_read<v_rd_off2(0, 0, 0)>(vb), h00 = tr_read<v_rd_off2(0, 0, 1)>(vb), l01 = tr_read<v_rd_off2(0, 1, 0)>(vb), h01 = tr_read<v_rd_off2(0, 1, 1)>(vb); \
          const s16x4 l10 = tr_read<v_rd_off2(1, 0, 0)>(vb), h10 = tr_read<v_rd_off2(1, 0, 1)>(vb), l11 = tr_read<v_rd_off2(1, 1, 0)>(vb), h11 = tr_read<v_rd_off2(1, 1, 1)>(vb); \
          asm volatile("s_waitcnt lgkmcnt(0)" ::: "memory"); __builtin_amdgcn_sched_barrier(0); \
          vf[0][0] = HG_PK(l00, h00); vf[0][1] = HG_PK(l01, h01); vf[1][0] = HG_PK(l10, h10); vf[1][1] = HG_PK(l11, h11); } while (0)
        f32x16 o[2] = {};
        { bf16x8 vf[2][2]; HG_VFRAGS();
#pragma unroll
        for (int d = 0; d < 2; ++d) { o[d] = __builtin_amdgcn_mfma_f32_32x32x16_bf16(pa0, vf[d][0], o[d], 0, 0, 0); o[d] = __builtin_amdgcn_mfma_f32_32x32x16_bf16(pa1, vf[d][1], o[d], 0, 0, 0); } }
#pragma unroll
        for (int kb = 0; kb < 2; ++kb)
#pragma unroll
            for (int s2 = 0; s2 < 2; ++s2) {
                const v2u qa = *(const LAS v2u*)(wl + QOFF + r32 * QP + (32 * kb + 16 * s2 + 4 * hi) * 2), qb2 = *(const LAS v2u*)(wl + QOFF + r32 * QP + (32 * kb + 16 * s2 + 8 + 4 * hi) * 2);
                v4u qw = {qa.x, qa.y, qb2.x, qb2.y}; const bf16x8 af = *reinterpret_cast<bf16x8*>(&qw);
#pragma unroll
                for (int d = 0; d < 2; ++d) { v4u sw = {cvtpk(S[kb][d][8 * s2 + 0], S[kb][d][8 * s2 + 1]), cvtpk(S[kb][d][8 * s2 + 2], S[kb][d][8 * s2 + 3]), cvtpk(S[kb][d][8 * s2 + 4], S[kb][d][8 * s2 + 5]), cvtpk(S[kb][d][8 * s2 + 6], S[kb][d][8 * s2 + 7])};
                    o[d] = __builtin_amdgcn_mfma_f32_32x32x16_bf16(af, *reinterpret_cast<bf16x8*>(&sw), o[d], 0, 0, 0); }
            }
        asm volatile("" ::: "memory");
        float Dk = 1.0f;
        for (int hf = 1; hf >= 0; --hf) {
            unsigned short rf[16], ri[16];
#pragma unroll
            for (int s1 = 0; s1 < 16; ++s1) { const int ss = 16 * hf + s1; const int r = hgrn_row(b, dir, pb + (ss < nval ? ss : 0)); const bf16* pr = P + (size_t)r * NINP + h * 64 + lane; rf[s1] = pr[fcol]; ri[s1] = pr[PC_I]; }
            __builtin_amdgcn_sched_barrier(0);
#pragma unroll
            for (int s1 = 15; s1 >= 0; --s1) { const int ss = 16 * hf + s1;
                unsigned kb16 = 0u, vv16 = 0u;
                if (ss < nval) { const float f = lbv + (1.0f - lbv) * sigm(bf2f(rf[s1])); const float fc = fminf(fmaxf(f, 1e-6f), 1.0f); kb16 = f2bf((1.0f - f) * Dk); Dk *= fc; vv16 = ri[s1]; }
                *(LAS unsigned short*)(wl + KOFF + lane * KBP + 2 * ss) = (unsigned short)kb16; *(LAS unsigned short*)(wl + QOFF + lane * KBP + 2 * ss) = (unsigned short)vv16;
            }
        }
        *(LAS float*)(wl + EOFF + 4 * lane) = Dk;
        LDS_WAIT(); asm volatile("" ::: "memory");
#pragma unroll
        for (int kb = 0; kb < 2; ++kb) {
            float ev[16];
#pragma unroll
            for (int r = 0; r < 16; ++r) ev[r] = *(const LAS float*)(wl + EOFF + 4 * (32 * kb + crow(r, hi)));
#pragma unroll
            for (int d = 0; d < 2; ++d)
#pragma unroll
                for (int r = 0; r < 16; ++r) S[kb][d][r] *= ev[r];
#pragma unroll
            for (int ks = 0; ks < 2; ++ks) {
                const bf16x8 af = *(const LAS bf16x8*)(wl + KOFF + (32 * kb + r32) * KBP + (16 * ks + 8 * hi) * 2);
#pragma unroll
                for (int d = 0; d < 2; ++d) { const bf16x8 bv = *(const LAS bf16x8*)(wl + QOFF + (32 * d + r32) * KBP + (16 * ks + 8 * hi) * 2);
                    S[kb][d] = __builtin_amdgcn_mfma_f32_32x32x16_bf16(af, bv, S[kb][d], 0, 0, 0); }
            }
        }
        if (dir == 0) {
#pragma unroll
            for (int r = 0; r < 16; ++r) { const int t = crow(r, hi); if (t < nval) { float* op = OF + (size_t)hgrn_row(b, dir, pb + t) * 256 + h * 64 + r32; op[0] = o[0][r]; op[32] = o[1][r]; } }
        } else {
#pragma unroll
            for (int rb = 0; rb < 16; rb += 8) { float f0[8], f1[8]; unsigned short z0[8], z1[8];
#pragma unroll
                for (int i = 0; i < 8; ++i) { const int t = crow(rb + i, hi); const int row = hgrn_row(b, dir, pb + (t < nval ? t : 0));
                    const float* op = OF + (size_t)row * 256 + h * 64 + r32; f0[i] = op[0]; f1[i] = op[32]; const bf16* gp = P + (size_t)row * NINP + PC_G + h * 64 + r32; z0[i] = gp[0]; z1[i] = gp[32]; }
                __builtin_amdgcn_sched_barrier(0);
#pragma unroll
                for (int i = 0; i < 8; ++i) { const int t = crow(rb + i, hi); const int row = hgrn_row(b, dir, pb + (t < nval ? t : 0));
                    const float x0 = o[0][rb + i] + f0[i], x1 = o[1][rb + i] + f1[i]; float sq = x0 * x0 + x1 * x1;
                    sq += __shfl_xor(sq, 1); sq += __shfl_xor(sq, 2); sq += __shfl_xor(sq, 4); sq += __shfl_xor(sq, 8); sq += __shfl_xor(sq, 16);
                    const float rs = __builtin_amdgcn_rsqf(sq * (1.f / 64.f) + EPS); const float gz0 = bf2f(z0[i]), gz1 = bf2f(z1[i]);
                    if (t < nval) { bf16* mp = MIX + (size_t)row * DM + h * 64 + r32; mp[0] = (bf16)f2bf(x0 * rs * g0 * (gz0 * sigm(gz0))); mp[32] = (bf16)f2bf(x1 * rs * g1 * (gz1 * sigm(gz1))); } }
            }
        }
        LDS_WAIT(); asm volatile("" ::: "memory");
    }
#undef HG_VFRAGS
#undef HG_PK
}
__device__ __forceinline__ void phase_hgrn_combine(const Args& a, int tid) {
    float* U = (float*)(a.ws + WS_U); const float* PCp = (const float*)(a.ws + WS_PC);
    for (int e = blockIdx.x * 512 + tid; e < NCHAIN * 4096; e += gridDim.x * 512) {
        const int ch = e >> 12, kv = e & 4095, k = kv >> 6; float S = 0.f;
        float* up = U + (size_t)ch * NCHUNK * 4096 + kv; const float* pp = PCp + ch * NCHUNK * 64 + k;
        for (int c0 = 0; c0 < NCHUNK; c0 += 16) { float t[16], d[16];
#pragma unroll
            for (int i = 0; i < 16; ++i) { t[i] = up[(size_t)(c0 + i) * 4096]; d[i] = pp[(c0 + i) * 64]; }
#pragma unroll
            for (int i = 0; i < 16; ++i) { up[(size_t)(c0 + i) * 4096] = S; S = fmaf(d[i], S, t[i]); } }
    }
}

__device__ __forceinline__ void phase_pool(const Args& a, LAS unsigned char* lds, int l, int tid, int wave, int lane) {
    const bf16* P = (const bf16*)(a.ws + WS_BIG); bf16* MIX = (bf16*)(a.ws + WS_XN);
    LAS float* UL = (LAS float*)lds;
    LAS float* PL = (LAS float*)(lds + 80 * 256 * 4) + wave * 64;
    const int g = wave & 3, half = wave >> 2, w = 2 << g;
    float Wc[64];
    const float* pw = AIN(18) + (size_t)(l * 4 + g) * 4096 + lane;
#pragma unroll
    for (int c = 0; c < 64; ++c) Wc[c] = pw[c * 64];
    const float psc = AIN(19)[l * 256 + g * 64 + lane];
    for (int task = blockIdx.x; task < 528; task += gridDim.x) {
        int rbase, slen, t0;
        if (task < 512) { rbase = (task >> 7) * LAT; slen = LAT; t0 = (task & 127) * 64; } else { const int q = task - 512; rbase = TL + (q >> 2) * CTXL; slen = CTXL; t0 = (q & 3) * 64; }
        __syncthreads();
        for (int jb = 0; jb < 20; jb += 10) { unsigned wv[10];
#pragma unroll
            for (int j = 0; j < 10; ++j) { const int i = tid + 512 * (jb + j), row = i >> 7, cp = i & 127, t = t0 - 8 + row; const int tc = t < 0 ? 0 : (t >= slen ? slen - 1 : t);
                wv[j] = *(const unsigned*)(P + (size_t)(rbase + tc) * NINP + PC_POOL + 2 * cp); }
            __builtin_amdgcn_sched_barrier(0);
#pragma unroll
            for (int j = 0; j < 10; ++j) { const int i = tid + 512 * (jb + j), row = i >> 7, cp = i & 127, t = t0 - 8 + row; const bool ok = (t >= 0 && t < slen);
                UL[row * 256 + 2 * cp] = ok ? bf2f(wv[j] & 0xffffu) : 0.f; UL[row * 256 + 2 * cp + 1] = ok ? bf2f(wv[j] >> 16) : 0.f; } }
        __syncthreads();
        for (int tt = 0; tt < 32; ++tt) { const int tl = half * 32 + tt, t = t0 + tl;
            int lo = t - (w >> 1), hi = t + w - 1 - (w >> 1); lo = lo < 0 ? 0 : lo; hi = hi > slen - 1 ? slen - 1 : hi;
            float s = 0.f; for (int q = lo; q <= hi; ++q) s += UL[(q - t0 + 8) * 256 + g * 64 + lane];
            PL[lane] = s / (float)(hi - lo + 1) - UL[(tl + 8) * 256 + g * 64 + lane];
            LDS_WAIT(); asm volatile("" ::: "memory");
            float o0 = 0.f, o1 = 0.f, o2 = 0.f, o3 = 0.f;
#pragma unroll
            for (int c4 = 0; c4 < 16; ++c4) { const f32x4 p4 = *(const LAS f32x4*)(PL + 4 * c4);
                o0 = fmaf(p4.x, Wc[4 * c4], o0); o1 = fmaf(p4.y, Wc[4 * c4 + 1], o1); o2 = fmaf(p4.z, Wc[4 * c4 + 2], o2); o3 = fmaf(p4.w, Wc[4 * c4 + 3], o3); }
            MIX[(size_t)(rbase + t) * DM + 768 + g * 64 + lane] = (bf16)f2bf(((o0 + o1) + (o2 + o3)) * psc);
            LDS_WAIT(); asm volatile("" ::: "memory"); }
    }
}

__device__ __forceinline__ void phase_qk_post(const Args& a, int l, int wave, int lane) {
    const bf16* P = (const bf16*)(a.ws + WS_BIG); bf16* Q = (bf16*)(a.ws + WS_Q); const bf16* KVR = (const bf16*)(a.ws + WS_KVRAW); bf16* Kb = (bf16*)(a.ws + WS_K); bf16* Vb = (bf16*)(a.ws + WS_V);
    const float* qgain = AIN(16) + l * 96; const float* kgain = AIN(17) + l * 96;
    const int h = lane >> 3, i = lane & 7;
    float gq[12], gk[12];
#pragma unroll
    for (int e = 0; e < 8; ++e) { gq[e] = qgain[i * 8 + e]; gk[e] = kgain[i * 8 + e]; }
    gq[8] = qgain[64 + 2 * i]; gq[9] = qgain[65 + 2 * i]; gq[10] = qgain[80 + 2 * i]; gq[11] = qgain[81 + 2 * i];
    gk[8] = kgain[64 + 2 * i]; gk[9] = kgain[65 + 2 * i]; gk[10] = kgain[80 + 2 * i]; gk[11] = kgain[81 + 2 * i];
    const int p0 = 2 * i; const float if0 = __builtin_amdgcn_exp2f(-(float)(p0 & 7) * (13.287712379549449f / 8.f)), if1 = __builtin_amdgcn_exp2f(-(float)((p0 + 1) & 7) * (13.287712379549449f / 8.f));
    const int gw = blockIdx.x * 8 + wave, NGW = gridDim.x * 8;
    if (gw == 0) {
        float mq = 0.f, mk = 0.f;
#pragma unroll
        for (int e = 0; e < 12; ++e) { mq = fmaxf(mq, fabsf(gq[e])); mk = fmaxf(mk, fabsf(gk[e])); }
        mq = fmaxf(mq, __shfl_xor(mq, 1)); mq = fmaxf(mq, __shfl_xor(mq, 2)); mq = fmaxf(mq, __shfl_xor(mq, 4));
        mk = fmaxf(mk, __shfl_xor(mk, 1)); mk = fmaxf(mk, __shfl_xor(mk, 2)); mk = fmaxf(mk, __shfl_xor(mk, 4));
        const float mlog2 = 1.02f * 96.0f * mq * mk * (att::SCALE * 1.4426950408889634f);
        if (lane == 0) ((float*)(a.ws + WS_ATTM))[l] = mlog2 > 40.0f ? -mlog2 : 0.0f;
    }
    for (int r0 = gw * 4; r0 < TT; r0 += NGW * 4) {
        v4u qw[4], kw[4], vw[4]; unsigned qa_[4], qb_[4], ka_[4], kb_[4];
#pragma unroll
        for (int q = 0; q < 4; ++q) { const int r = r0 + q; const bf16* qp = Q + (size_t)r * 768 + h * 96; const bf16* kp = KVR + (size_t)r * 1024 + h * 128; const bf16* pe = P + (size_t)r * NINP + PC_KPE;
            qw[q] = *(const v4u*)(qp + i * 8); qa_[q] = *(const unsigned*)(qp + 64 + 2 * i); qb_[q] = *(const unsigned*)(qp + 80 + 2 * i);
            kw[q] = *(const v4u*)(kp + i * 8); vw[q] = *(const v4u*)(kp + 64 + i * 8); ka_[q] = *(const unsigned*)(pe + 2 * i); kb_[q] = *(const unsigned*)(pe + 16 + 2 * i); }
        __builtin_amdgcn_sched_barrier(0);
#pragma unroll
        for (int q = 0; q < 4; ++q) { const int r = r0 + q;
        const bool lat = r < TL; int kvrow; float c0 = 1.f, s0 = 0.f, c1 = 1.f, s1 = 0.f;
        if (lat) { const int b = r >> 13, t = r & 8191; kvrow = b * KVS + t; const float pos = (float)(p0 < 8 ? (t >> 6) : (t & 63));
            float a0_ = pos * if0 * 0.15915494309189535f, a1_ = pos * if1 * 0.15915494309189535f; a0_ -= floorf(a0_); a1_ -= floorf(a1_);
            c0 = __builtin_amdgcn_cosf(a0_); s0 = __builtin_amdgcn_sinf(a0_); c1 = __builtin_amdgcn_cosf(a1_); s1 = __builtin_amdgcn_sinf(a1_); }
        else { const int rc = r - TL; kvrow = (rc >> 8) * KVS + LAT + (rc & 255); }
        { bf16* qp = Q + (size_t)r * 768 + h * 96; float x[12];
          const v4u w = qw[q]; const unsigned wa = qa_[q], wb = qb_[q];
          x[0] = bf2f(w.x & 0xffffu); x[1] = bf2f(w.x >> 16); x[2] = bf2f(w.y & 0xffffu); x[3] = bf2f(w.y >> 16); x[4] = bf2f(w.z & 0xffffu); x[5] = bf2f(w.z >> 16); x[6] = bf2f(w.w & 0xffffu); x[7] = bf2f(w.w >> 16);
          x[8] = bf2f(wa & 0xffffu); x[9] = bf2f(wa >> 16); x[10] = bf2f(wb & 0xffffu); x[11] = bf2f(wb >> 16);
          float s = 0.f;
#pragma unroll
          for (int e = 0; e < 12; ++e) s += x[e] * x[e];
          s += __shfl_xor(s, 1); s += __shfl_xor(s, 2); s += __shfl_xor(s, 4);
          const float rs = (att::SCALE * 1.4426950408889634f) / sqrtf(s * (1.f / 96.f) + EPS);
#pragma unroll
          for (int e = 0; e < 12; ++e) x[e] = x[e] * rs * gq[e];
          const float a0 = x[8] * c0 - x[10] * s0, b0 = x[8] * s0 + x[10] * c0, a1 = x[9] * c1 - x[11] * s1, b1 = x[9] * s1 + x[11] * c1;
          v4u o; o.x = pk2(x[0], x[1]); o.y = pk2(x[2], x[3]); o.z = pk2(x[4], x[5]); o.w = pk2(x[6], x[7]);
          *(v4u*)(qp + i * 8) = o; *(unsigned*)(qp + 64 + 2 * i) = pk2(a0, a1); *(unsigned*)(qp + 80 + 2 * i) = pk2(b0, b1); }
        { float x[12];
          const v4u w = kw[q]; const v4u vv = vw[q]; const unsigned wa = ka_[q], wb = kb_[q];
          x[0] = bf2f(w.x & 0xffffu); x[1] = bf2f(w.x >> 16); x[2] = bf2f(w.y & 0xffffu); x[3] = bf2f(w.y >> 16); x[4] = bf2f(w.z & 0xffffu); x[5] = bf2f(w.z >> 16); x[6] = bf2f(w.w & 0xffffu); x[7] = bf2f(w.w >> 16);
          x[8] = bf2f(wa & 0xffffu); x[9] = bf2f(wa >> 16); x[10] = bf2f(wb & 0xffffu); x[11] = bf2f(wb >> 16);
          float s = 0.f;
#pragma unroll
          for (int e = 0; e < 12; ++e) s += x[e] * x[e];
          s += __shfl_xor(s, 1); s += __shfl_xor(s, 2); s += __shfl_xor(s, 4);
          const float rs = 1.0f / sqrtf(s * (1.f / 96.f) + EPS);
#pragma unroll
          for (int e = 0; e < 12; ++e) x[e] = x[e] * rs * gk[e];
          const float a0 = x[8] * c0 - x[10] * s0, b0 = x[8] * s0 + x[10] * c0, a1 = x[9] * c1 - x[11] * s1, b1 = x[9] * s1 + x[11] * c1;
          bf16* ko = Kb + (size_t)kvrow * 768 + h * 96; v4u o; o.x = pk2(x[0], x[1]); o.y = pk2(x[2], x[3]); o.z = pk2(x[4], x[5]); o.w = pk2(x[6], x[7]);
          *(v4u*)(ko + i * 8) = o; *(unsigned*)(ko + 64 + 2 * i) = pk2(a0, a1); *(unsigned*)(ko + 80 + 2 * i) = pk2(b0, b1);
          *(v4u*)(Vb + (size_t)kvrow * 512 + h * 64 + i * 8) = vv; }
        }
    }
}
#define XB_TMO      128
#define XB_XCNT(j)  (256  + 64 * (j))
#define XB_XSUB(j)  (1280 + 64 * (j))
#define XB_XGEN(j)  (2304 + 64 * (j))
#define XB_TOP      3328
#define XB_TOPGEN   3392
#define XCD_BAR_WORDS 3456
#define XB_SPIN_CAP (1u << 18)

__device__ __forceinline__ unsigned xb_ld(unsigned* p)              { return __hip_atomic_load(p, __ATOMIC_RELAXED, __HIP_MEMORY_SCOPE_AGENT); }
__device__ __forceinline__ unsigned xb_add(unsigned* p, unsigned v) { return __hip_atomic_fetch_add(p, v, __ATOMIC_RELAXED, __HIP_MEMORY_SCOPE_AGENT); }
__device__ __forceinline__ unsigned xb_xcc_id() { return (unsigned)__builtin_amdgcn_s_getreg((3 << 11) | 20) & 0xFu; }
#define XB_SPIN(cond, bar) do { unsigned _sp = 0; while (cond) { __builtin_amdgcn_s_sleep(1); \
    if ((++_sp & 255u) == 0u) { if (xb_ld(&(bar)[XB_TMO])) break; if (_sp > XB_SPIN_CAP) { atomicAdd(&(bar)[XB_TMO], 1u); break; } } } } while (0)

struct XcdBarrier {
    unsigned* bar; unsigned x;
    volatile LAS unsigned* st;
};

__device__ __forceinline__ XcdBarrier xcd_barrier_post(unsigned* bar, volatile LAS unsigned* st) {
    XcdBarrier b; b.bar = bar; b.x = xb_xcc_id(); b.st = st;
    if (threadIdx.x == 0) (void)xb_add(&bar[XB_XCNT(b.x)], 1u);
    return b;
}
__device__ __forceinline__ void xcd_barrier_complete(unsigned* bar, unsigned x, unsigned& nloc, unsigned& nx) {
    const unsigned G = gridDim.x * gridDim.y * gridDim.z;
    unsigned sum, cnt, mine, sp = 0u;
    for (;;) {
        sum = 0u; cnt = 0u; mine = 0u;
#pragma unroll
        for (unsigned j = 0; j < 16; ++j) { const unsigned c = xb_ld(&bar[XB_XCNT(j)]); sum += c; cnt += (c > 0u) ? 1u : 0u; mine = (j == x) ? c : mine; }
        if (sum == G) break;
        __builtin_amdgcn_s_sleep(1);
        if ((++sp & 255u) == 0u) { if (xb_ld(&bar[XB_TMO])) break; if (sp > XB_SPIN_CAP) { atomicAdd(&bar[XB_TMO], 1u); break; } }
    }
    nloc = mine > 0u ? mine : 1u; nx = cnt > 0u ? cnt : 1u;
}

__device__ __forceinline__ void xcd_barrier(const XcdBarrier& b) {
    asm volatile("s_waitcnt vmcnt(0)" ::: "memory");
    __syncthreads();
    if (threadIdx.x == 0) {
        unsigned* bar = b.bar;
        __builtin_amdgcn_s_waitcnt(0);
        unsigned nloc = b.st[0], nx = b.st[1];
        if (nloc == 0u) { xcd_barrier_complete(bar, b.x, nloc, nx); b.st[0] = nloc; b.st[1] = nx; }
        const unsigned old = xb_add(&bar[XB_XSUB(b.x)], 1u);
        const unsigned gen = old / nloc;
        if (old + 1u == (gen + 1u) * nloc) {
            __builtin_amdgcn_fence(__ATOMIC_RELEASE, "agent");
            asm volatile("s_waitcnt vmcnt(0)" ::: "memory");
            const unsigned og = xb_add(&bar[XB_TOP], 1u);
            const unsigned tg = og / nx;
            if (og + 1u == (tg + 1u) * nx) xb_add(&bar[XB_TOPGEN], 1u);
            else XB_SPIN(xb_ld(&bar[XB_TOPGEN]) == tg, bar);
            __builtin_amdgcn_fence(__ATOMIC_ACQUIRE, "agent");
            xb_add(&bar[XB_XGEN(b.x)], 1u);
            asm volatile("s_waitcnt vmcnt(0)" ::: "memory");
        } else {
            XB_SPIN(xb_ld(&bar[XB_XGEN(b.x)]) == gen, bar);
            __builtin_amdgcn_fence(__ATOMIC_ACQUIRE, "agent");
            asm volatile("s_waitcnt vmcnt(0)" ::: "memory");
        }
    }
    __syncthreads();
}


__device__ __forceinline__ void ctx_resid_gemm(const bf16* A, const bf16* Bt, int K, float* xc, const float* gate, float coef, LAS unsigned char* lds, int tid, int wave, int lane) {
    typedef short bf16x8_t __attribute__((ext_vector_type(8)));
    for (int tile = blockIdx.x; tile < 256; tile += gridDim.x) {
        const int r0 = (tile >> 4) * 64, c0 = (tile & 15) * 64, ks = K >> 3, kbeg = wave * ks;
        const bf16* ap = A + (size_t)(r0 + (lane & 15)) * K + kbeg + 8 * (lane >> 4);
        const bf16* bp = Bt + (size_t)(c0 + (lane & 15)) * K + kbeg + 8 * (lane >> 4);
        f32x4 acc[4][4];
#pragma unroll
        for (int i = 0; i < 4; ++i)
#pragma unroll
            for (int j = 0; j < 4; ++j) acc[i][j] = (f32x4){0.f, 0.f, 0.f, 0.f};
        for (int k0 = 0; k0 < ks; k0 += 32) {
            bf16x8_t af[4], bfr[4];
#pragma unroll
            for (int i = 0; i < 4; ++i) { af[i] = *(const bf16x8_t*)(ap + (size_t)(16 * i) * K + k0); bfr[i] = *(const bf16x8_t*)(bp + (size_t)(16 * i) * K + k0); }
#pragma unroll
            for (int i = 0; i < 4; ++i)
#pragma unroll
                for (int j = 0; j < 4; ++j) acc[i][j] = __builtin_amdgcn_mfma_f32_16x16x32_bf16(af[i], bfr[j], acc[i][j], 0, 0, 0);
        }
        LAS float* pw = (LAS float*)lds + wave * (64 * 68);
        __syncthreads();
#pragma unroll
        for (int i = 0; i < 4; ++i)
#pragma unroll
            for (int j = 0; j < 4; ++j)
#pragma unroll
                for (int rg = 0; rg < 4; ++rg) pw[(16 * i + 4 * (lane >> 4) + rg) * 68 + 16 * j + (lane & 15)] = acc[i][j][rg];
        __syncthreads();
        const int row = tid >> 3, col = (tid & 7) * 8;
        f32x4 s0 = {0.f, 0.f, 0.f, 0.f}, s1 = {0.f, 0.f, 0.f, 0.f};
#pragma unroll
        for (int w = 0; w < 8; ++w) { const LAS float* q = (const LAS float*)lds + w * (64 * 68) + row * 68 + col; s0 += *(const LAS f32x4*)q; s1 += *(const LAS f32x4*)(q + 4); }
        float* xp = xc + (size_t)(r0 + row) * DM + c0 + col; const float* gp = gate + c0 + col;
        const f32x4 g0 = *(const f32x4*)gp * coef, g1 = *(const f32x4*)(gp + 4) * coef;
        const f32x4 x0 = *(const f32x4*)xp, x1 = *(const f32x4*)(xp + 4);
        *(f32x4*)xp = x0 + g0 * s0; *(f32x4*)(xp + 4) = x1 + g1 * s1;
    }
}
__device__ __forceinline__ void phase_attn(const Args& a, unsigned char* lds_generic, int l, int lane_in) {
    const bf16* Q = (const bf16*)(a.ws + WS_Q); const bf16* Kb = (const bf16*)(a.ws + WS_K); const bf16* Vb = (const bf16*)(a.ws + WS_V); bf16* MIX = (bf16*)(a.ws + WS_XN);
    const int nunits = 1024 + (l < DEPTH - 1 ? 32 : 0);
    float negM;
    negM = __uint_as_float(__builtin_amdgcn_readfirstlane(__float_as_uint(((const float*)(a.ws + WS_ATTM))[l])));
    for (int u = blockIdx.x; u < nunits; u += gridDim.x) {
        if (u < 1024) {
            const int rnd = u >> 8, w = u & 255, bh = rnd * 8 + (w & 7), qb = w >> 3, b = bh >> 3, h = bh & 7;
            const size_t qrow = (size_t)b * LAT + qb * 256;
            att::attn_body(Q + qrow * 768 + h * 96, Kb + (size_t)b * KVS * 768 + h * 96, Vb + (size_t)b * KVS * 512 + h * 64, MIX + qrow * DM + 256 + h * 64, KVS, (char*)lds_generic, negM);
        } else {
            const int bh = u - 1024, b = bh >> 3, h = bh & 7; const size_t qrow = (size_t)TL + b * CTXL;
            att::attn_body(Q + qrow * 768 + h * 96, Kb + ((size_t)b * KVS + LAT) * 768 + h * 96, Vb + ((size_t)b * KVS + LAT) * 512 + h * 64, MIX + qrow * DM + 256 + h * 64, CTXL, (char*)lds_generic, negM);
        }
    }
}

template <bool COOP>
__global__ void __launch_bounds__(512, 2) mk_fwd(Args a) {
    extern __shared__ __attribute__((aligned(16))) unsigned char lds[];
    LAS unsigned char* L = (LAS unsigned char*)lds;
    const int G = gridDim.x, NGW = G * 8;
    unsigned char* wb = a.ws + WS_W;
    if (COOP) { volatile LAS unsigned* st = (volatile LAS unsigned*)(L + LDS_BYTES - 64); if (threadIdx.x < 2) st[threadIdx.x] = 0u; __syncthreads(); }
    for (int ph = a.ph_lo; ph < a.ph_hi; ++ph) {
        int tid_l = threadIdx.x; asm volatile("" : "+v"(tid_l));
        const int tid = tid_l, lane = tid & 63, wave = __builtin_amdgcn_readfirstlane(tid >> 6), gw = blockIdx.x * 8 + wave;
        if (ph == 0) { if (COOP && blockIdx.x == 0) { for (int i = tid; i < (int)(WS_BAR_BYTES / 4); i += 512) ((unsigned*)(a.ws + WS_BAR))[i] = 0u; }
            phase_init(a, L, tid, wave, lane); }
        else {
            const int l = (ph - 1) / NPH_LAYER, k = (ph - 1) % NPH_LAYER;
            const bool last = (l == DEPTH - 1);
            const float* xl = (l == 0 && k <= 2) ? AIN(0) : a.out;
            const float* xc = (l == 0 && k <= 2) ? AIN(2) : (const float*)(a.ws + WS_XC);
            float* xc_out = (float*)(a.ws + WS_XC);
            const float* mod = (const float*)(a.ws + WS_MOD) + (size_t)l * 5 * 9216;
            const int mrows = (last && k >= 9) ? TL : TT;
            if (k == 0) { phase_wconv(a, L, l, wave, lane); phase_norm(a, l, 0, xl, xc, TT, wave, lane); }
            else if (k == 3) phase_norm(a, l, 3, xl, xc, TT, wave, lane);
            else if (k == 10) phase_norm(a, l, 6, xl, xc, mrows, wave, lane);
            else if (k == 1 || k == 11) {
                pg8::Gemm g{(const bf16*)(a.ws + WS_XN), (const bf16*)(wb + (k == 1 ? W_F1IN : W_F2IN)), mrows, 2 * FF, DM};
                pg8::StaticOrder S; S.init(mrows, 2 * FF, G, (int)blockIdx.x);
                pg8::EpiSwiglu E{(bf16*)(a.ws + WS_BIG), FF};

#ifndef NO_G1
pg8::gemm_phase<pg8::EpiSwiglu, pg8::StaticOrder, true, true>(L, g, S, E);
#endif

            }
            else if (k == 2 || k == 9 || k == 12) {
                const bool isout = (k == 9);
                const int Kd = isout ? DM : FF; const bf16* Ap = (const bf16*)(a.ws + (isout ? WS_XN : WS_BIG)); const bf16* Bp = (const bf16*)(wb + (k == 2 ? W_F1OUT : (isout ? W_OUT : W_F2OUT)));
                pg8::Gemm g{Ap, Bp, TL, DM, Kd};
                pg8::StaticOrder S; S.init(TL, DM, G, (int)blockIdx.x);
                pg8::EpiResid E{xl, xc, a.out, xc_out, mod + (k == 2 ? 2 : (isout ? 5 : 8)) * 1024, 9216, isout ? 1.0f : 0.5f};

#ifndef NO_G2
pg8::gemm_phase<pg8::EpiResid, pg8::StaticOrder, false, true>(L, g, S, E);
#endif
                if (mrows == TT) {
                    if (l == 0 && k == 2) { for (int tile = blockIdx.x; tile < 256; tile += G) { const int r = (tile >> 4) * 64 + (tid >> 3), c = (tile & 15) * 64 + (tid & 7) * 8;
                            const float* sp = xc + (size_t)r * DM + c; float* dp = xc_out + (size_t)r * DM + c; *(f32x4*)dp = *(const f32x4*)sp; *(f32x4*)(dp + 4) = *(const f32x4*)(sp + 4); } }
                    ctx_resid_gemm(Ap + (size_t)TL * Kd, Bp, Kd, xc_out, mod + 4 * 9216 + (k == 2 ? 2 : (isout ? 5 : 8)) * 1024, isout ? 1.0f : 0.5f, L, tid, wave, lane);
                }

            }
            else if (k == 4 || k == 6) {
                if (k == 6) phase_hgrn_combine(a, tid);
                const int ng = (k == 4) ? 1 : 2;
                for (int gi = 0; gi < ng; ++gi) {
                    pg8::Gemm g; pg8::EpiBf16P E;
                    if (k == 4)       { g = pg8::Gemm{(const bf16*)(a.ws + WS_XN), (const bf16*)(wb + W_IN), TT, NINP, DM}; E = pg8::EpiBf16P{(bf16*)(a.ws + WS_BIG), NINP}; }
                    else if (gi == 0) { g = pg8::Gemm{(const bf16*)(a.ws + WS_R1), (const bf16*)(wb + W_UQ), TT, 768, 384}; E = pg8::EpiBf16P{(bf16*)(a.ws + WS_Q), 768}; }
                    else              { g = pg8::Gemm{(const bf16*)(a.ws + WS_CKVN), (const bf16*)(wb + W_UKV), TT, 1024, 256}; E = pg8::EpiBf16P{(bf16*)(a.ws + WS_KVRAW), 1024}; }
                    pg8::StaticOrder S; S.init(g.M, g.N, G, (int)blockIdx.x);

#ifndef NO_G3
pg8::gemm_phase<pg8::EpiBf16P, pg8::StaticOrder, true, true>(L, g, S, E);
#endif

                }
            }
            else if (k == 5) {
                for (int rep5 = 0; rep5 < PROBE_REP5; ++rep5) {
                phase_mla_norm(a, l, wave, lane);
                for (int t = gw; t < NCHAIN * NCHUNK; t += NGW) hgrn_state_mfma(a, L + wave * 16384, l, t / NCHUNK, t % NCHUNK, lane);
                __syncthreads();

#ifndef NO_POOL
                phase_pool(a, L, l, tid, wave, lane);
#endif
                __syncthreads(); }

            }
            else if (k == 7) {

#ifndef NO_QK
                phase_qk_post(a, l, wave, lane);
#endif

                for (int t = gw; t < (NCHAIN / 2) * NCHUNK; t += NGW) { const int chx = (t / NCHUNK) * 2, jx = t % NCHUNK;

#ifndef NO_FB
if (__builtin_amdgcn_readfirstlane(((const int*)(a.ws + WS_HGF))[chx * NCHUNK + jx])) hgrn_out_seq(a, l, chx, jx, lane);
                    else
#endif
 hgrn_out_mfma(a, L + wave * 16384, l, chx, jx, lane); }
            }
            else if (k == 8) {

#ifndef NO_ATTN
                for (int rep = 0; rep < PROBE_ATTN_REP; ++rep) phase_attn(a, lds, l, lane);
#endif

                __syncthreads();
                for (int t = gw; t < (NCHAIN / 2) * NCHUNK; t += NGW) { const int chx = (t / NCHUNK) * 2 + 1, jx = t % NCHUNK;

#ifndef NO_FB
if (__builtin_amdgcn_readfirstlane(((const int*)(a.ws + WS_HGF))[chx * NCHUNK + jx])) hgrn_out_seq(a, l, chx, jx, lane);
                    else
#endif
 hgrn_out_mfma(a, L + wave * 16384, l, chx, jx, lane); }
            }
        }
        if (COOP) { if (ph + 1 < a.ph_hi) { if (ph == a.ph_lo) { cg::this_grid().sync(); (void)xcd_barrier_post((unsigned*)(a.ws + WS_BAR), (volatile LAS unsigned*)(L + LDS_BYTES - 64)); } else { XcdBarrier bar; bar.bar = (unsigned*)(a.ws + WS_BAR); bar.x = xb_xcc_id(); bar.st = (volatile LAS unsigned*)(L + LDS_BYTES - 64); xcd_barrier(bar); } } }
        else __syncthreads();
    }
}

#ifndef PROBE_ATTN_REP
#define PROBE_ATTN_REP 1
#endif
#ifndef MK_LAUNCH_PER_PHASE
#define MK_LAUNCH_PER_PHASE 0
#endif
extern "C" void kernel_launch(void* const* d_in, const int* in_sizes, int n_in, void* d_out, int out_size, void* d_ws, size_t ws_size, hipStream_t stream) {
    static int grid = 0;
    if (grid == 0) {
        if (n_in != 22 || in_sizes[0] != TL * DM || out_size != TL * DM || ws_size < WS_END) { fprintf(stderr, "kernel_launch: shape/workspace mismatch (n_in %d, ws %zu, need %zu); nothing launched\n", n_in, ws_size, (size_t)WS_END); grid = -1; return; }
        int dev = 0, cus = 0, per_cu = 0;
        if (hipGetDevice(&dev) != hipSuccess || hipDeviceGetAttribute(&cus, hipDeviceAttributeMultiprocessorCount, dev) != hipSuccess) { grid = -1; return; }
        if (hipFuncSetAttribute((const void*)mk_fwd<true>, hipFuncAttributeMaxDynamicSharedMemorySize, LDS_BYTES) != hipSuccess ||
            hipFuncSetAttribute((const void*)mk_fwd<false>, hipFuncAttributeMaxDynamicSharedMemorySize, LDS_BYTES) != hipSuccess) { fprintf(stderr, "kernel_launch: hipFuncSetAttribute failed\n"); grid = -1; return; }
        if (hipOccupancyMaxActiveBlocksPerMultiprocessor(&per_cu, (const void*)mk_fwd<true>, 512, LDS_BYTES) != hipSuccess || per_cu < 1) { fprintf(stderr, "kernel_launch: occupancy query says %d blocks per CU\n", per_cu); per_cu = 1; }
        (void)hipGetLastError();
        grid = cus;
    }
    if (grid < 0) return;
    Args a{};
    for (int i = 0; i < 22; ++i) a.in[i] = (const float*)d_in[i];
    a.out = (float*)d_out; a.ws = (unsigned char*)d_ws;
#if MK_LAUNCH_PER_PHASE
    for (int ph = 0; ph < NPHASES; ++ph) { a.ph_lo = ph; a.ph_hi = ph + 1; hipLaunchKernelGGL(mk_fwd<false>, dim3(grid), dim3(512), LDS_BYTES, stream, a); }
#else
    a.ph_lo = 0; a.ph_hi = NPHASES;
    void* args[] = {&a};
    hipError_t e = hipLaunchCooperativeKernel((const void*)mk_fwd<true>, dim3(grid), dim3(512), args, LDS_BYTES, stream);
    if (e != hipSuccess) fprintf(stderr, "kernel_launch: cooperative launch failed: %s (grid %d)\n", hipGetErrorString(e), grid);
#endif
}
```

```cpp
#include <hip/hip_runtime.h>
#include <hip/hip_cooperative_groups.h>
#include <cstdio>
#include <cstdint>
namespace cg = cooperative_groups;
#ifndef PROBE_ATTN_REP
#define PROBE_ATTN_REP 1
#endif
#ifndef PROBE_REP5
#define PROBE_REP5 1
#endif
#ifndef PROBE_REPC
#define PROBE_REPC 1
#endif
namespace pg8 {
#define PG8_LAS __attribute__((address_space(3)))
typedef unsigned short bf16_t;
typedef short bf16x8 __attribute__((ext_vector_type(8)));
typedef float f32x4 __attribute__((ext_vector_type(4)));
typedef unsigned u32x4 __attribute__((ext_vector_type(4)));
constexpr int BM = 256, BK = 64, HALF = 128, HTB = HALF * BK * 2  , STAGE_BYTES = 8 * HTB, NXCD = 8, WGM = 8;

__host__ __device__ __forceinline__ int lds_byte(int r, int c) { const int st = (r >> 4) * 2 + (c >> 5), rr = r & 15, cc = c & 31, ob = rr * 64 + cc * 2; return st * 1024 + (ob ^ (((ob >> 9) & 1) << 5)); }
__host__ __device__ __forceinline__ void stage_rc(int b, int& R, int& C) { const int st = b / 1024, sb = b % 1024, swz = sb ^ (((sb >> 9) & 1) << 5); R = (st >> 1) * 16 + swz / 64; C = (st & 1) * 32 + (swz % 64) / 2; }
__host__ __device__ __forceinline__ int perm32(int rho) { const int n = rho >> 4, i = rho & 15; return 8 * (i >> 2) + 4 * n + (i & 3); }

struct Unit { int pm, pn; };
struct Gemm { const bf16_t* A; const bf16_t* Bt; int M, N, K; };

struct StaticOrder {
    int nM, nN, nwg, G, c;
    __host__ __device__ void init(int M, int N, int G_, int c_) { nM = M / BM; nN = N / BM; nwg = nM * nN; G = G_; c = c_; }
    __host__ __device__ bool next(int i, Unit& u) const {
        const long L = (long)i * G + c; if (L >= nwg) return false;
        int wgid = (int)L; { const int q = nwg / NXCD, r = nwg % NXCD, xcd = wgid % NXCD, off = wgid / NXCD; wgid = (xcd < r ? xcd * (q + 1) : r * (q + 1) + (xcd - r) * q) + off; }
        const int nig = WGM * nN, gid = wgid / nig, fm = gid * WGM, gsz = (nM - fm) < WGM ? (nM - fm) : WGM;
        u.pm = fm + ((wgid % nig) % gsz); u.pn = (wgid % nig) / gsz; return true;
    }
    __device__ __forceinline__ void a_ready(const Unit&) const {}
    __device__ __forceinline__ void done(const Unit&) const {}
};

__device__ __forceinline__ unsigned cvt_pk_bf16(float lo, float hi) { unsigned r; asm volatile("v_cvt_pk_bf16_f32 %0, %1, %2" : "=v"(r) : "v"(lo), "v"(hi)); return r; }
struct EpiBf16P {
    static constexpr bool PERM = true, AFTER_DRAIN = false;
    bf16_t* O; int ldc;
    __device__ __forceinline__ void operator()(const f32x4 (&acc)[2][2][4][2], const Unit& u, int wr, int wc, int fr, int fq) const {
        const int row0 = u.pm * BM + wr * 64 + fr; const int col0 = u.pn * BM + wc * 32 + 8 * fq;
#pragma unroll
        for (int ai = 0; ai < 2; ++ai)
#pragma unroll
            for (int m = 0; m < 4; ++m) { bf16_t* rowp = O + (size_t)(row0 + ai * HALF + m * 16) * ldc + col0;
#pragma unroll
                for (int bj = 0; bj < 2; ++bj) { const f32x4 v0 = acc[ai][bj][m][0], v1 = acc[ai][bj][m][1];
                    u32x4 w; w.x = cvt_pk_bf16(v0[0], v0[1]); w.y = cvt_pk_bf16(v0[2], v0[3]); w.z = cvt_pk_bf16(v1[0], v1[1]); w.w = cvt_pk_bf16(v1[2], v1[3]);
                    *(u32x4*)(rowp + bj * HALF) = w; } }
    }
};
__device__ __forceinline__ float silu_f(float g) { return g * __builtin_amdgcn_rcpf(1.0f + __builtin_amdgcn_exp2f(-1.4426950408889634f * g)); }
struct EpiSwiglu {
    static constexpr bool PERM = true, AFTER_DRAIN = false;
    bf16_t* H; int ldh;
    __device__ __forceinline__ void operator()(const f32x4 (&acc)[2][2][4][2], const Unit& u, int wr, int wc, int fr, int fq) const {
        const int row0 = u.pm * BM + wr * 64 + fr; const int col0 = u.pn * HALF + wc * 32 + 8 * fq;
#pragma unroll
        for (int ai = 0; ai < 2; ++ai)
#pragma unroll
            for (int m = 0; m < 4; ++m) { bf16_t* rowp = H + (size_t)(row0 + ai * HALF + m * 16) * ldh + col0;
                const f32x4 g0 = acc[ai][0][m][0], g1 = acc[ai][0][m][1], u0 = acc[ai][1][m][0], u1 = acc[ai][1][m][1];
                u32x4 w; w.x = cvt_pk_bf16(silu_f(g0[0]) * u0[0], silu_f(g0[1]) * u0[1]); w.y = cvt_pk_bf16(silu_f(g0[2]) * u0[2], silu_f(g0[3]) * u0[3]);
                w.z = cvt_pk_bf16(silu_f(g1[0]) * u1[0], silu_f(g1[1]) * u1[1]); w.w = cvt_pk_bf16(silu_f(g1[2]) * u1[2], silu_f(g1[3]) * u1[3]);
                *(u32x4*)rowp = w; }
    }
};
struct EpiResid {
    static constexpr bool PERM = false, AFTER_DRAIN = false;
    const float* base_l; const float* base_c; float* out_l; float* out_c; const float* gate; int gstride; float coef;
    __device__ __forceinline__ void operator()(const f32x4 (&acc)[2][2][4][2], const Unit& u, int wr, int wc, int fr, int fq) const {
        const int trow = u.pm * BM; const bool lat = trow < 32768;
        const float* bp = lat ? base_l + (size_t)trow * 1024 : base_c + (size_t)(trow - 32768) * 1024;
        float* op = lat ? out_l + (size_t)trow * 1024 : out_c + (size_t)(trow - 32768) * 1024;
        const float* gp = gate + (size_t)(lat ? (trow >> 13) : 4) * gstride;
        const int rloc = wr * 64 + fr; const int col0 = u.pn * BM + wc * 32 + 4 * fq;
#pragma unroll
        for (int bj = 0; bj < 2; ++bj)
#pragma unroll
            for (int n = 0; n < 2; ++n) { const int cc = col0 + bj * HALF + 16 * n; const f32x4 gv = *(const f32x4*)(gp + cc) * coef;
                f32x4 b[2][4];
#pragma unroll
                for (int ai = 0; ai < 2; ++ai)
#pragma unroll
                    for (int m = 0; m < 4; ++m) b[ai][m] = *(const f32x4*)(bp + (size_t)(rloc + ai * HALF + m * 16) * 1024 + cc);
                __builtin_amdgcn_sched_barrier(0);
#pragma unroll
                for (int ai = 0; ai < 2; ++ai)
#pragma unroll
                    for (int m = 0; m < 4; ++m) *(f32x4*)(op + (size_t)(rloc + ai * HALF + m * 16) * 1024 + cc) = b[ai][m] + gv * acc[ai][bj][m][n];
                __builtin_amdgcn_sched_barrier(0); }
    }
};
template <class Epi, class Sched, bool ALIGN_EPI = false, bool SP2 = false>
__device__ __forceinline__ void gemm_phase(PG8_LAS unsigned char* lds, const Gemm g, const Sched& S, const Epi& E) {
    int tid_l = threadIdx.x; asm volatile("" : "+v"(tid_l));
    const int tid = tid_l, wid = __builtin_amdgcn_readfirstlane(tid >> 6), lane = tid & 63, wr = wid >> 2, wc = wid & 3, fr = lane & 15, fq = lane >> 4;
    const int K = g.K, nt = K / BK;
    unsigned voffA[2], voffB[2];
#pragma unroll
    for (int i = 0; i < 2; ++i) { int R, C; stage_rc(tid * 16 + i * 8192, R, C); const int Rb = Epi::PERM ? ((R & ~31) + perm32(R & 31)) : R;
        voffA[i] = (unsigned)(R * K + C) * 2u; voffB[i] = (unsigned)(Rb * K + C) * 2u; }
    const size_t kstep = (size_t)(BK * 2);
    const size_t hstep = (size_t)HALF * K * 2;
    const size_t tstep = 2 * hstep;
    const unsigned ldsw = (unsigned)wid * 1024u;
    const int aoff = lds_byte(wr * 64 + fr, fq * 8), boff = lds_byte(wc * 32 + fr, fq * 8);
#define PG8_SA(b, h) (((b) * 2 + (h)) * HTB)
#define PG8_SB(b, h) ((4 + (b) * 2 + (h)) * HTB)
#define PG8_STAGE(bufoff, gbase, voff) do { _Pragma("unroll") for (int _i = 0; _i < 2; ++_i) \
        __builtin_amdgcn_global_load_lds((const unsigned*)((const char*)(gbase) + (voff)[_i]), (PG8_LAS unsigned*)(lds + (bufoff) + ldsw + _i * 8192), 16, 0, 0); } while (0)
#define PG8_LDA(dst, b, h) do { _Pragma("unroll") for (int m = 0; m < 4; ++m) _Pragma("unroll") for (int k = 0; k < 2; ++k) dst[m][k] = *(const PG8_LAS bf16x8*)(lds + PG8_SA(b, h) + aoff + m * 2048 + k * 1024); } while (0)
#define PG8_LDB(dst, b, h) do { _Pragma("unroll") for (int n = 0; n < 2; ++n) _Pragma("unroll") for (int k = 0; k < 2; ++k) dst[n][k] = *(const PG8_LAS bf16x8*)(lds + PG8_SB(b, h) + boff + n * 2048 + k * 1024); } while (0)
#define PG8_MMA(ai, bj, At, Bt) do { __builtin_amdgcn_s_setprio(1); _Pragma("unroll") for (int m = 0; m < 4; ++m) _Pragma("unroll") for (int n = 0; n < 2; ++n) _Pragma("unroll") for (int k = 0; k < 2; ++k) \
        acc[ai][bj][m][n] = __builtin_amdgcn_mfma_f32_16x16x32_bf16(Bt[n][k], At[m][k], acc[ai][bj][m][n], 0, 0, 0); __builtin_amdgcn_s_setprio(0); } while (0)
#define PG8_WAIT_V(n) asm volatile("s_waitcnt vmcnt(" #n ")" ::: "memory")
#define PG8_WAIT_L(n) asm volatile("s_waitcnt lgkmcnt(" #n ")" ::: "memory")
#define PG8_BAR __builtin_amdgcn_s_barrier()
#define PG8_SCHED __builtin_amdgcn_sched_barrier(0)
    Unit cur, nxt; int ui = 0;
    if (!S.next(0, cur)) return;
    f32x4 acc[2][2][4][2];
#pragma unroll
    for (int a = 0; a < 2; ++a)
#pragma unroll
        for (int b = 0; b < 2; ++b)
#pragma unroll
            for (int m = 0; m < 4; ++m)
#pragma unroll
                for (int n = 0; n < 2; ++n) acc[a][b][m][n] = (f32x4){0.f, 0.f, 0.f, 0.f};
    bf16x8 At[4][2], B0[2][2], B1[2][2];
    const char* cA = (const char*)g.A + (size_t)cur.pm * tstep; const char* cB = (const char*)g.Bt + (size_t)cur.pn * tstep;
    S.a_ready(cur);
    if constexpr (SP2) {
        PG8_STAGE(PG8_SB(0, 0), cB, voffB); PG8_STAGE(PG8_SB(0, 1), cB + hstep, voffB); PG8_STAGE(PG8_SA(0, 0), cA, voffA); PG8_STAGE(PG8_SA(0, 1), cA + hstep, voffA);
        if (wr == 1) PG8_BAR;
        PG8_WAIT_V(2); PG8_BAR;
        PG8_STAGE(PG8_SB(1, 0), cB + kstep, voffB); PG8_STAGE(PG8_SA(1, 0), cA + kstep, voffA); PG8_STAGE(PG8_SB(1, 1), cB + hstep + kstep, voffB);
        PG8_WAIT_V(6); PG8_BAR;
    } else {
        PG8_STAGE(PG8_SB(0, 0), cB, voffB); PG8_STAGE(PG8_SA(0, 0), cA, voffA); PG8_STAGE(PG8_SB(0, 1), cB + hstep, voffB); PG8_STAGE(PG8_SA(0, 1), cA + hstep, voffA);
        if (wr == 1) PG8_BAR;
        PG8_WAIT_V(4); PG8_BAR;
        PG8_STAGE(PG8_SB(1, 0), cB + kstep, voffB); PG8_STAGE(PG8_SA(1, 0), cA + kstep, voffA); PG8_STAGE(PG8_SB(1, 1), cB + hstep + kstep, voffB);
        PG8_WAIT_V(6); PG8_BAR;
    }
    for (;;) {
        const bool has_next = S.next(ui + 1, nxt);
        const char* nA = has_next ? (const char*)g.A + (size_t)nxt.pm * tstep : cA; const char* nB = has_next ? (const char*)g.Bt + (size_t)nxt.pn * tstep : cB;
        for (int t = 0; t < nt; t += 2) {
            const bool last = (t == nt - 2);
            const char* a1 = cA + (size_t)(t + 1) * kstep;
            const char* a2 = last ? nA : cA + (size_t)(t + 2) * kstep; const char* b2 = last ? nB : cB + (size_t)(t + 2) * kstep;
            const char* a3 = a2 + kstep; const char* b3 = b2 + kstep;
            if (last && has_next) S.a_ready(nxt);
            if constexpr (SP2) {
            PG8_LDB(B0, 0, 0); PG8_LDB(B1, 0, 1); PG8_SCHED; PG8_LDA(At, 0, 0); PG8_STAGE(PG8_SA(1, 1), a1 + hstep, voffA);
            PG8_WAIT_V(8); PG8_WAIT_L(0); PG8_BAR; PG8_MMA(0, 0, At, B0); PG8_MMA(0, 1, At, B1); PG8_BAR; PG8_SCHED;
            PG8_LDA(At, 0, 1); PG8_STAGE(PG8_SB(0, 0), b2, voffB); PG8_STAGE(PG8_SB(0, 1), b2 + hstep, voffB); PG8_STAGE(PG8_SA(0, 0), a2, voffA);
            PG8_WAIT_V(8); PG8_WAIT_L(0); PG8_BAR; PG8_MMA(1, 0, At, B0); PG8_MMA(1, 1, At, B1); PG8_BAR; PG8_SCHED;
            PG8_LDB(B0, 1, 0); PG8_LDB(B1, 1, 1); PG8_SCHED; PG8_LDA(At, 1, 0); PG8_STAGE(PG8_SA(0, 1), a2 + hstep, voffA);
            PG8_WAIT_V(8); PG8_WAIT_L(0); PG8_BAR; PG8_MMA(0, 0, At, B0); PG8_MMA(0, 1, At, B1); PG8_BAR; PG8_SCHED;
            PG8_LDA(At, 1, 1); PG8_STAGE(PG8_SB(1, 0), b3, voffB); PG8_STAGE(PG8_SB(1, 1), b3 + hstep, voffB); PG8_STAGE(PG8_SA(1, 0), a3, voffA);
            PG8_WAIT_V(8); PG8_WAIT_L(0); PG8_BAR; PG8_MMA(1, 0, At, B0); PG8_MMA(1, 1, At, B1); PG8_BAR; PG8_SCHED;
            } else {
            PG8_LDB(B0, 0, 0); PG8_SCHED; PG8_LDA(At, 0, 0); PG8_STAGE(PG8_SA(1, 1), a1 + hstep, voffA);
            PG8_WAIT_L(8); PG8_BAR; PG8_WAIT_L(0); PG8_MMA(0, 0, At, B0); PG8_BAR; PG8_SCHED;
            PG8_LDB(B1, 0, 1); PG8_STAGE(PG8_SB(0, 0), b2, voffB);
            PG8_BAR; PG8_WAIT_L(0); PG8_MMA(0, 1, At, B1); PG8_BAR;
            PG8_LDA(At, 0, 1); PG8_STAGE(PG8_SA(0, 0), a2, voffA);
            PG8_BAR; PG8_WAIT_L(0); PG8_MMA(1, 0, At, B0); PG8_BAR; PG8_SCHED;
            PG8_STAGE(PG8_SB(0, 1), b2 + hstep, voffB);
            PG8_WAIT_V(6); PG8_BAR; PG8_MMA(1, 1, At, B1); PG8_BAR;
            PG8_LDB(B0, 1, 0); PG8_SCHED; PG8_LDA(At, 1, 0); PG8_STAGE(PG8_SA(0, 1), a2 + hstep, voffA);
            PG8_WAIT_L(8); PG8_BAR; PG8_WAIT_L(0); PG8_MMA(0, 0, At, B0); PG8_BAR; PG8_SCHED;
            PG8_LDB(B1, 1, 1); PG8_STAGE(PG8_SB(1, 0), b3, voffB);
            PG8_BAR; PG8_WAIT_L(0); PG8_MMA(0, 1, At, B1); PG8_BAR;
            PG8_LDA(At, 1, 1); PG8_STAGE(PG8_SA(1, 0), a3, voffA);
            PG8_BAR; PG8_WAIT_L(0); PG8_MMA(1, 0, At, B0); PG8_BAR; PG8_SCHED;
            PG8_STAGE(PG8_SB(1, 1), b3 + hstep, voffB);
            PG8_WAIT_V(6); PG8_BAR; PG8_MMA(1, 1, At, B1); PG8_BAR;
            }
        }
        if constexpr (ALIGN_EPI) { if (wr == 0) PG8_BAR; }
        if constexpr (!Epi::AFTER_DRAIN) { E(acc, cur, wr, wc, fr, fq); S.done(cur); }
        if (!has_next) break;
#pragma unroll
        for (int a = 0; a < 2; ++a)
#pragma unroll
            for (int b = 0; b < 2; ++b)
#pragma unroll
                for (int m = 0; m < 4; ++m)
#pragma unroll
                    for (int n = 0; n < 2; ++n) acc[a][b][m][n] = (f32x4){0.f, 0.f, 0.f, 0.f};
        cur = nxt; cA = nA; cB = nB; ++ui;
        if constexpr (ALIGN_EPI) { if (wr == 1) PG8_BAR; }
    }
    PG8_WAIT_V(0);
    if constexpr (!ALIGN_EPI) { if (wr == 0) PG8_BAR; }
    PG8_BAR;
    if constexpr (Epi::AFTER_DRAIN) { E.fused(acc, cur, wr, wc, fr, fq, lds, wid, lane); S.done(cur); }
#undef PG8_SA
#undef PG8_SB
#undef PG8_STAGE
#undef PG8_LDA
#undef PG8_LDB
#undef PG8_MMA
#undef PG8_WAIT_V
#undef PG8_WAIT_L
#undef PG8_BAR
#undef PG8_SCHED
}
}

namespace att {
typedef unsigned short bf16;
constexpr int DQK = 96, DV = 64, NW = 8, QBLK = 32, KVBLK = 64, LDQ = 768, LDK = 768, LDV = 512, LDO = 1024;
constexpr float SCALE = 0.10206207261596577f;
constexpr size_t SHM_V = KVBLK * 128 * 2, SHM_K = KVBLK * 128 * 2, SHM_ATTN = 3 * SHM_V + 3 * SHM_K + NW * 64 * 4;
using bf16x8 = __attribute__((ext_vector_type(8))) short;
using s16x4  = __attribute__((ext_vector_type(4))) short;
using f32x16 = __attribute__((ext_vector_type(16))) float;
using u32x4  = __attribute__((ext_vector_type(4))) unsigned;
#define KSWZ(row, colB) ((row) * 256 + ((colB) ^ (((row) & 7) << 4)))
#define SBAR() __builtin_amdgcn_sched_barrier(0)
__device__ __forceinline__ int crow(int r, int hi) { return (r & 3) + 8 * (r >> 2) + 4 * hi; }
__device__ __forceinline__ unsigned cvtpk(float lo, float hi) { unsigned r; asm volatile("v_cvt_pk_bf16_f32 %0, %1, %2" : "=v"(r) : "v"(lo), "v"(hi)); return r; }
__device__ __forceinline__ bf16x8 ld8(const bf16* p) { return *reinterpret_cast<const bf16x8*>(p); }
__device__ __forceinline__ void partialSM(f32x16& p0) {
#pragma unroll
  for (int r = 0; r < 16; ++r) p0[r] = __builtin_amdgcn_exp2f(p0[r]);
}
__device__ __forceinline__ void finishSM(f32x16& p0, f32x16& p1, float& l_reg, bf16x8& pa0, bf16x8& pa1, bf16x8& pa2, bf16x8& pa3) {
#pragma unroll
  for (int r = 0; r < 16; ++r) p1[r] = __builtin_amdgcn_exp2f(p1[r]);
  float ps = 0;
#pragma unroll
  for (int r = 0; r < 16; ++r) ps += p0[r];
#pragma unroll
  for (int r = 0; r < 16; ++r) ps += p1[r];
  { auto rr = __builtin_amdgcn_permlane32_swap(__float_as_uint(ps), __float_as_uint(ps), false, false);
    ps = __uint_as_float(rr[0]) + __uint_as_float(rr[1]); }
  l_reg += ps;
#define PK4(P, BASE, OUT) do { unsigned a0 = cvtpk(P[BASE + 0], P[BASE + 1]), a1 = cvtpk(P[BASE + 2], P[BASE + 3]);   \
    unsigned b0 = cvtpk(P[BASE + 4], P[BASE + 5]), b1 = cvtpk(P[BASE + 6], P[BASE + 7]);                              \
    auto r0 = __builtin_amdgcn_permlane32_swap(a0, b0, false, false); auto r1 = __builtin_amdgcn_permlane32_swap(a1, b1, false, false); \
    u32x4 w = {r0[0], r1[0], r0[1], r1[1]}; OUT = *reinterpret_cast<bf16x8*>(&w); } while (0)
  PK4(p0, 0, pa0); PK4(p0, 8, pa1); PK4(p1, 0, pa2); PK4(p1, 8, pa3);
#undef PK4
}
__device__ __forceinline__ void qkt(f32x16& p0, f32x16& p1, const bf16* Ks, const bf16x8* qr, int r32, int hi, float negM) {
  p0 = f32x16{}; p1 = f32x16{};
#pragma unroll
  for (int d0 = 0; d0 < 6; ++d0) { int cb = (d0 * 16 + hi * 8) * 2;
    bf16x8 b0 = *reinterpret_cast<const bf16x8*>((const char*)Ks + KSWZ(r32, cb));
    bf16x8 b1 = *reinterpret_cast<const bf16x8*>((const char*)Ks + KSWZ(32 + r32, cb));
    p0 = __builtin_amdgcn_mfma_f32_32x32x16_bf16(b0, qr[d0], p0, 0, 0, 0);
    p1 = __builtin_amdgcn_mfma_f32_32x32x16_bf16(b1, qr[d0], p1, 0, 0, 0); }
  if (__builtin_expect(negM != 0.f, 0)) {
#pragma unroll
    for (int r = 0; r < 16; ++r) { p0[r] += negM; p1[r] += negM; } }
}
__device__ __forceinline__ int v_st(int k, int c) { const int kk = (k & ~0xC) | ((k & 4) << 1) | ((k & 8) >> 1); return ((kk >> 3) * 4 + (c >> 5)) * 512 + ((kk & 7) * 32 + (c & 31)) * 2; }
__device__ __forceinline__ int v_rd_base(int lane) { return ((lane & 3) << 3) | (((lane >> 2) & 3) << 6) | (((lane >> 4) & 1) << 5) | (((lane >> 5) & 1) << 8); }
constexpr int v_rd_off(int d0, int ks, int half) { return d0 * 512 + ks * 4096 + half * 2048; }
template <int OFF> __device__ __forceinline__ s16x4 tr_read(int vb) {
  s16x4 r; asm volatile("ds_read_b64_tr_b16 %0, %1 offset:%2" : "=&v"(r) : "v"(vb), "i"(OFF) : "memory"); return r;
}
template <int D0> __device__ __forceinline__ void pv_one(f32x16& od, int vb, bf16x8 pa0, bf16x8 pa1, bf16x8 pa2, bf16x8 pa3) {
  const s16x4 l0 = tr_read<v_rd_off(D0, 0, 0)>(vb), h0 = tr_read<v_rd_off(D0, 0, 1)>(vb), l1 = tr_read<v_rd_off(D0, 1, 0)>(vb), h1 = tr_read<v_rd_off(D0, 1, 1)>(vb);
  const s16x4 l2 = tr_read<v_rd_off(D0, 2, 0)>(vb), h2 = tr_read<v_rd_off(D0, 2, 1)>(vb), l3 = tr_read<v_rd_off(D0, 3, 0)>(vb), h3 = tr_read<v_rd_off(D0, 3, 1)>(vb);
  asm volatile("s_waitcnt lgkmcnt(0)" ::: "memory"); SBAR();
#define PK(L, H) (bf16x8){L[0], L[1], L[2], L[3], H[0], H[1], H[2], H[3]}
  od = __builtin_amdgcn_mfma_f32_32x32x16_bf16(pa0, PK(l0, h0), od, 0, 0, 0);
  od = __builtin_amdgcn_mfma_f32_32x32x16_bf16(pa1, PK(l1, h1), od, 0, 0, 0);
  od = __builtin_amdgcn_mfma_f32_32x32x16_bf16(pa2, PK(l2, h2), od, 0, 0, 0);
  od = __builtin_amdgcn_mfma_f32_32x32x16_bf16(pa3, PK(l3, h3), od, 0, 0, 0);
#undef PK
}
__device__ __forceinline__ void pv_d0(f32x16* o, int vb, bf16x8 pa0, bf16x8 pa1, bf16x8 pa2, bf16x8 pa3) {
  pv_one<0>(o[0], vb, pa0, pa1, pa2, pa3); pv_one<1>(o[1], vb, pa0, pa1, pa2, pa3);
}
__device__ __forceinline__ void attn_body(const bf16* __restrict__ Qb, const bf16* __restrict__ Kh, const bf16* __restrict__ Vh, bf16* __restrict__ Ob, int seq, char* lds, float negM) {
  int tid_l = threadIdx.x; asm volatile("" : "+v"(tid_l));
  const int tid = tid_l, wid = tid >> 6, lane = tid & 63, r32 = lane & 31, hi = lane >> 5;
  static_assert(SHM_V == SHM_K, "one byte offset addresses both rings");
  bf16* V_lds = (bf16*)lds; bf16* K_lds = (bf16*)(lds + 3 * SHM_V);
  float* ws = (float*)(lds + 3 * SHM_V + 3 * SHM_K) + wid * 64; float* li_l = ws;
  float l_reg = 0; f32x16 o[2] = {}; bf16x8 qr[6];
  const bf16* Qw = Qb + (long)(wid * QBLK + r32) * LDQ + hi * 8;
#pragma unroll
  for (int d0 = 0; d0 < 6; ++d0) qr[d0] = ld8(Qw + d0 * 16);
  const int sr = tid >> 4, sc = (tid & 15) * 8, vst0 = v_st(sr, sc), vst1 = v_st(32 + sr, sc);
  const int kcol = sc < 96 ? sc : 88, vcol = sc < 64 ? sc : 56;
  const int vb0 = (int)(uintptr_t)V_lds + v_rd_base(lane);
  struct { bf16x8 vs0, vs1, ks0, ks1; } sr_[2];
#define SLOAD(i, k0) do { sr_[i].vs0 = ld8(&Vh[(long)((k0) + sr) * LDV + vcol]); sr_[i].vs1 = ld8(&Vh[(long)((k0) + 32 + sr) * LDV + vcol]); \
    sr_[i].ks0 = ld8(&Kh[(long)((k0) + sr) * LDK + kcol]); sr_[i].ks1 = ld8(&Kh[(long)((k0) + 32 + sr) * LDK + kcol]); } while (0)
#define SWRITE(boff, i) do { if (sc < 64) { *(bf16x8*)((char*)V_lds + (boff) + vst0) = sr_[i].vs0;          \
    *(bf16x8*)((char*)V_lds + (boff) + vst1) = sr_[i].vs1; } int kc = sc * 2;               \
    if (sc < 96) { *(bf16x8*)((char*)K_lds + (boff) + KSWZ(sr, kc)) = sr_[i].ks0;                       \
    *(bf16x8*)((char*)K_lds + (boff) + KSWZ(32 + sr, kc)) = sr_[i].ks1; } } while (0)
  f32x16 pA0, pA1, pB0, pB1; bf16x8 pa0, pa1, pa2, pa3; const int NT = seq / KVBLK;
  if (__builtin_amdgcn_readfirstlane(tid) >= 256) __builtin_amdgcn_s_setprio(1);
  SLOAD(0, 0); SLOAD(1, KVBLK);
  SWRITE(0, 0); __syncthreads();
  SWRITE((int)SHM_V, 1);
  qkt(pA0, pA1, K_lds, qr, r32, hi, negM); partialSM(pA0);
  if (2 < NT) SLOAD(0, 2 * KVBLK);
  __syncthreads();
  int o_prev = 0, o_cur = (int)SHM_V, o_next = 2 * (int)SHM_V;
#define ASTEP(PC0, PC1, PP0, PP1, WSLOT, LSLOT, LCOND, LTILE) do { \
    SWRITE(o_next, WSLOT); \
    SBAR(); qkt(PC0, PC1, (bf16*)((char*)K_lds + o_cur), qr, r32, hi, negM); \
    finishSM(PP0, PP1, l_reg, pa0, pa1, pa2, pa3); SBAR(); \
    if (LCOND) SLOAD(LSLOT, (LTILE) * KVBLK); SBAR(); \
    pv_d0(o, vb0 + o_prev, pa0, pa1, pa2, pa3); partialSM(PC0); \
    __syncthreads(); \
    { const int t_ = o_prev; o_prev = o_cur; o_cur = o_next; o_next = t_; } } while (0)
  for (int j = 1; j + 1 < NT; j += 2) {
    ASTEP(pB0, pB1, pA0, pA1, 0, 1, true, j + 2);
    ASTEP(pA0, pA1, pB0, pB1, 1, 0, j + 3 < NT, j + 3);
  }
#undef ASTEP
  SBAR(); qkt(pB0, pB1, (bf16*)((char*)K_lds + o_cur), qr, r32, hi, negM);
  finishSM(pA0, pA1, l_reg, pa0, pa1, pa2, pa3); SBAR();
  pv_d0(o, vb0 + o_prev, pa0, pa1, pa2, pa3); partialSM(pB0);
  finishSM(pB0, pB1, l_reg, pa0, pa1, pa2, pa3); SBAR();
  pv_d0(o, vb0 + o_cur, pa0, pa1, pa2, pa3);
  __builtin_amdgcn_s_setprio(0);
  if (hi == 0) li_l[r32] = l_reg; asm volatile("s_waitcnt lgkmcnt(0)" ::: "memory");
  float rli[16];
#pragma unroll
  for (int r = 0; r < 16; ++r) rli[r] = __builtin_amdgcn_rcpf(li_l[crow(r, hi)]);
  bf16* Ow = Ob + (long)(wid * QBLK) * LDO;
#pragma unroll
  for (int r = 0; r < 16; ++r) { int orow = crow(r, hi);
#pragma unroll
    for (int d0 = 0; d0 < 2; ++d0) { const float v = o[d0][r] * rli[r]; unsigned u = __float_as_uint(v); u = (u + 0x7fffu + ((u >> 16) & 1u)) >> 16; Ow[(long)orow * LDO + d0 * 32 + r32] = (bf16)u; } }
  __syncthreads();
#undef SLOAD
#undef SWRITE
}
#undef KSWZ
#undef SBAR
}

typedef unsigned short bf16;
#define LAS __attribute__((address_space(3)))
typedef float f32x4 __attribute__((ext_vector_type(4)));
typedef unsigned v4u __attribute__((ext_vector_type(4)));
typedef unsigned v2u __attribute__((ext_vector_type(2)));
constexpr int TL = 32768, TC = 1024, TT = TL + TC, DM = 1024, FF = 2816, NINP = 2304, LAT = 8192, CTXL = 256, KVS = LAT + CTXL, DEPTH = 4;
constexpr int PC_Q = 0, PC_FF = 256, PC_FB = 512, PC_I = 768, PC_G = 1024, PC_CQ = 1280, PC_CKV = 1664, PC_KPE = 1920, PC_POOL = 1952;
constexpr float EPS = 1e-6f;
constexpr int NCHUNK = 128, NCHAIN = 32, CHL = 66, SUBN = 11, NSUB = 6;
constexpr size_t MiB = 1u << 20;
constexpr size_t WS_BAR = 800 * 1024, WS_BAR_BYTES = 16384;
constexpr size_t WS_MOD = 0, WS_LB = 768 * 1024, WS_XC = 1 * MiB, WS_W = 5 * MiB, WS_XN = 46 * MiB, WS_BIG = 112 * MiB, WS_V = WS_BIG + 149 * MiB,
                 WS_R1 = 294 * MiB, WS_CKVN = WS_R1 + 25 * MiB, WS_Q = 336 * MiB, WS_KVRAW = 386 * MiB, WS_K = 452 * MiB, WS_U = 502 * MiB, WS_PC = 568 * MiB, WS_END = 570 * MiB;
constexpr size_t W_F1IN = 0, W_F1OUT = 11534336, W_F2IN = 17301504, W_F2OUT = 28835840, W_IN = 34603008, W_OUT = 39321600, W_UQ = 41418752, W_UKV = 42008576;
constexpr size_t WS_ATTM = WS_LB + 16384;
constexpr size_t WS_HGF = WS_PC + 1 * MiB;
constexpr int LDS_BYTES = 147456;
constexpr int NPH_LAYER = 13, NPHASES = 1 + DEPTH * NPH_LAYER;

struct Args { const float* in[22]; float* out; unsigned char* ws; int ph_lo, ph_hi; };
#define AIN(i) argin(a, i)


__device__ __forceinline__ const float* argin(const Args& a, int i) { asm volatile("" : "+s"(i)); return a.in[i]; }
__device__ __forceinline__ float bf2f(unsigned h) { return __uint_as_float(h << 16); }
__device__ __forceinline__ unsigned f2bf(float f) { unsigned u = __float_as_uint(f); return (u + 0x7fffu + ((u >> 16) & 1u)) >> 16; }
__device__ __forceinline__ unsigned pk2(float lo, float hi) { return f2bf(lo) | (f2bf(hi) << 16); }
__device__ __forceinline__ float wave_sum(float v) {
#pragma unroll
    for (int o = 1; o < 64; o <<= 1) v += __shfl_xor(v, o);
    return v;
}
__device__ __forceinline__ float sigm(float z) { return __builtin_amdgcn_rcpf(1.0f + __builtin_amdgcn_exp2f(-1.4426950408889634f * z)); }
#define LDS_WAIT() asm volatile("s_waitcnt lgkmcnt(0)" ::: "memory")

__device__ __forceinline__ void transpose_item(const float* W, int K, int Nsrc, bf16* WT, int k0, int dst0, int src0, LAS float* scr, int lane) {
    if (src0 >= 0) {
        float tmp[32];
#pragma unroll
        for (int i = 0; i < 32; ++i) { const int kk = 2 * i + (lane >> 5); tmp[i] = __builtin_nontemporal_load(&W[(size_t)(k0 + kk) * Nsrc + src0 + (lane & 31)]); }
        __builtin_amdgcn_sched_barrier(0);
#pragma unroll
        for (int i = 0; i < 32; ++i) { const int kk = 2 * i + (lane >> 5); scr[kk * 33 + (lane & 31)] = tmp[i]; }
    }
    LDS_WAIT(); asm volatile("" ::: "memory");
    const int c = lane & 7;
#pragma unroll
    for (int j = 0; j < 4; ++j) { const int n = (lane >> 3) + 8 * j; const LAS float* s = scr + (8 * c) * 33 + n;
        v4u o;
        if (src0 >= 0) { o.x = pk2(s[0 * 33], s[1 * 33]); o.y = pk2(s[2 * 33], s[3 * 33]); o.z = pk2(s[4 * 33], s[5 * 33]); o.w = pk2(s[6 * 33], s[7 * 33]); }
        else { unsigned z = 0u; asm volatile("" : "+v"(z)); o.x = z; o.y = z; o.z = z; o.w = z; }
        *(v4u*)(WT + (size_t)(dst0 + n) * K + k0 + 8 * c) = o; }
    LDS_WAIT(); asm volatile("" ::: "memory");
}
__device__ __forceinline__ void modnorm_row(const float* xrow, const float* shift, const float* scale, bf16* orow, int lane) {
    const f32x4* xr = (const f32x4*)xrow + lane; const f32x4* sh = (const f32x4*)shift + lane; const f32x4* sc = (const f32x4*)scale + lane;
    f32x4 v[4]; float s = 0.f;
#pragma unroll
    for (int j = 0; j < 4; ++j) { v[j] = xr[64 * j]; s += (v[j].x * v[j].x + v[j].y * v[j].y) + (v[j].z * v[j].z + v[j].w * v[j].w); }
    const float rstd = 1.0f / sqrtf(wave_sum(s) * (1.f / 1024.f) + EPS);
    v2u* o8 = (v2u*)orow + lane;
#pragma unroll
    for (int j = 0; j < 4; ++j) { const f32x4 a = sc[64 * j], b = sh[64 * j]; const f32x4 y = v[j] * rstd * (a + 1.0f) + b;
        v2u w; w.x = pk2(y.x, y.y); w.y = pk2(y.z, y.w); o8[64 * j] = w; }
}
__device__ __forceinline__ const float* xrow_ptr(const float* xl, const float* xc, int r) { return r < TL ? xl + (size_t)r * DM : xc + (size_t)(r - TL) * DM; }

__device__ __forceinline__ void phase_init(const Args& a, LAS unsigned char* lds, int tid, int wave, int lane) {
    const float* c = AIN(1); const float* c_ctx = AIN(3); const float* w_mod = AIN(4); const float* b_mod = AIN(5);
    float* mod = (float*)(a.ws + WS_MOD);
    LAS float* AL = (LAS float*)lds; LAS float* RL = (LAS float*)(lds + 20480);
    for (int i = tid; i < 5 * 1024; i += 512) { const int s = i >> 10, k = i & 1023; const float v = s < 4 ? c[s * 1024 + k] : c_ctx[k]; AL[i] = v * sigm(v); }
    __syncthreads();
    for (int item = blockIdx.x; item < 4 * 144; item += gridDim.x) {
        const int l = item / 144, n0 = (item % 144) * 64;
        const float* W = w_mod + (size_t)l * 1024 * 9216 + n0 + lane;
        float acc0 = 0.f, acc1 = 0.f, acc2 = 0.f, acc3 = 0.f, acc4 = 0.f; const int k0 = wave * 128;
        for (int kb = 0; kb < 128; kb += 32) { float w[32];
#pragma unroll
            for (int kk = 0; kk < 32; ++kk) w[kk] = __builtin_nontemporal_load(&W[(size_t)(k0 + kb + kk) * 9216]);
            __builtin_amdgcn_sched_barrier(0);
#pragma unroll
            for (int kk = 0; kk < 32; ++kk) { const int k = k0 + kb + kk;
                acc0 += AL[k] * w[kk]; acc1 += AL[1024 + k] * w[kk]; acc2 += AL[2048 + k] * w[kk]; acc3 += AL[3072 + k] * w[kk]; acc4 += AL[4096 + k] * w[kk]; } }
        RL[(wave * 5 + 0) * 64 + lane] = acc0; RL[(wave * 5 + 1) * 64 + lane] = acc1; RL[(wave * 5 + 2) * 64 + lane] = acc2; RL[(wave * 5 + 3) * 64 + lane] = acc3; RL[(wave * 5 + 4) * 64 + lane] = acc4;
        __syncthreads();
        if (tid < 320) { const int s = tid >> 6; float sum = b_mod[l * 9216 + n0 + lane];
#pragma unroll
            for (int w = 0; w < 8; ++w) sum += RL[(w * 5 + s) * 64 + lane];
            mod[(size_t)(l * 5 + s) * 9216 + n0 + lane] = sum; }
        __syncthreads();
    }
    if (blockIdx.x == 0) {
        const float* lg = AIN(10); float* LB = (float*)(a.ws + WS_LB);
        const float z0 = lg[tid], z1 = lg[512 + tid], z2 = lg[1024 + tid], z3 = lg[1536 + tid];
        const float mx = fmaxf(fmaxf(z0, z1), fmaxf(z2, z3));
        const float e0 = __expf(z0 - mx), e1 = __expf(z1 - mx), e2 = __expf(z2 - mx), e3 = __expf(z3 - mx); const float inv = 1.0f / (e0 + e1 + e2 + e3);
        LB[tid] = 0.f; LB[512 + tid] = e1 * inv; LB[1024 + tid] = (e1 + e2) * inv; LB[1536 + tid] = (e1 + e2 + e3) * inv;
    }
}

__device__ __forceinline__ void phase_wconv(const Args& a, LAS unsigned char* lds, int l, int wave, int lane) {
    LAS float* scr = (LAS float*)(lds + wave * 8448);
    unsigned char* wb = a.ws + WS_W;
    const int gw = blockIdx.x * 8 + wave, NGW = gridDim.x * 8;
    constexpr int I1 = 16 * 176, I2 = 44 * 32, I5 = 16 * 72, I6 = 16 * 32, I7 = 6 * 24, I8 = 4 * 32, NIT = 2 * (I1 + I2) + I5 + I6 + I7 + I8;
    for (int it = gw; it < NIT; it += NGW) {
        int r = it;
        if (r < 2 * I1) { const int f = r / I1; r -= f * I1; const int kb = r / 176, nb = r % 176, n0 = nb * 32; const int src = ((n0 >> 7) & 1) * FF + (n0 >> 8) * 128 + (n0 & 127);
            transpose_item(AIN(f ? 20 : 6) + (size_t)l * 1024 * 5632, 1024, 5632, (bf16*)(wb + (f ? W_F2IN : W_F1IN)), kb * 64, n0, src, scr, lane); continue; }
        r -= 2 * I1;
        if (r < 2 * I2) { const int f = r / I2; r -= f * I2; const int kb = r / 32, nb = r % 32;
            transpose_item(AIN(f ? 21 : 7) + (size_t)l * FF * 1024, FF, 1024, (bf16*)(wb + (f ? W_F2OUT : W_F1OUT)), kb * 64, nb * 32, nb * 32, scr, lane); continue; }
        r -= 2 * I2;
        if (r < I5) { const int kb = r / 72, nb = r % 72; transpose_item(AIN(8) + (size_t)l * 1024 * 2208, 1024, 2208, (bf16*)(wb + W_IN), kb * 64, nb * 32, nb < 69 ? nb * 32 : -1, scr, lane); continue; }
        r -= I5;
        if (r < I6) { const int kb = r / 32, nb = r % 32; transpose_item(AIN(9) + (size_t)l * 1024 * 1024, 1024, 1024, (bf16*)(wb + W_OUT), kb * 64, nb * 32, nb * 32, scr, lane); continue; }
        r -= I6;
        if (r < I7) { const int kb = r / 24, nb = r % 24; transpose_item(AIN(13) + (size_t)l * 384 * 768, 384, 768, (bf16*)(wb + W_UQ), kb * 64, nb * 32, nb * 32, scr, lane); continue; }
        r -= I7;
        { const int kb = r / 32, nb = r % 32; transpose_item(AIN(15) + (size_t)l * 256 * 1024, 256, 1024, (bf16*)(wb + W_UKV), kb * 64, nb * 32, nb * 32, scr, lane); }
    }
}
__device__ __forceinline__ void phase_norm(const Args& a, int l, int j0, const float* xl, const float* xc, int nrows, int wave, int lane) {
    const float* mod = (const float*)(a.ws + WS_MOD) + (size_t)l * 5 * 9216; bf16* XN = (bf16*)(a.ws + WS_XN);
    const int gw = blockIdx.x * 8 + wave, NGW = gridDim.x * 8;
    for (int r0 = gw * 4; r0 < nrows; r0 += NGW * 4) {
        const int s = r0 < TL ? (r0 >> 13) : 4; const float* m = mod + (size_t)s * 9216 + j0 * 1024;
        const f32x4* sh = (const f32x4*)m + lane; const f32x4* sc = (const f32x4*)(m + 1024) + lane;
        f32x4 v[4][4];
#pragma unroll
        for (int q = 0; q < 4; ++q) { const f32x4* xr = (const f32x4*)xrow_ptr(xl, xc, r0 + q) + lane;
#pragma unroll
            for (int j = 0; j < 4; ++j) v[q][j] = xr[64 * j]; }
        f32x4 av[4], bv[4];
#pragma unroll
        for (int j = 0; j < 4; ++j) { av[j] = sc[64 * j] + 1.0f; bv[j] = sh[64 * j]; }
        __builtin_amdgcn_sched_barrier(0);
#pragma unroll
        for (int q = 0; q < 4; ++q) { float ss = 0.f;
#pragma unroll
            for (int j = 0; j < 4; ++j) ss += (v[q][j].x * v[q][j].x + v[q][j].y * v[q][j].y) + (v[q][j].z * v[q][j].z + v[q][j].w * v[q][j].w);
            const float rstd = 1.0f / sqrtf(wave_sum(ss) * (1.f / 1024.f) + EPS);
            v2u* o8 = (v2u*)(XN + (size_t)(r0 + q) * DM) + lane;
#pragma unroll
            for (int j = 0; j < 4; ++j) { const f32x4 y = v[q][j] * rstd * av[j] + bv[j]; v2u w; w.x = pk2(y.x, y.y); w.y = pk2(y.z, y.w); o8[64 * j] = w; } }
    }
}
__device__ __forceinline__ void phase_mla_norm(const Args& a, int l, int wave, int lane) {
    const bf16* P = (const bf16*)(a.ws + WS_BIG); bf16* CQN = (bf16*)(a.ws + WS_R1); bf16* CKVN = (bf16*)(a.ws + WS_CKVN);
    const float* qg = AIN(12) + l * 384; const float* kg = AIN(14) + l * 256;
    const int gw = blockIdx.x * 8 + wave, NGW = gridDim.x * 8;
    float gq[6], gk[4];
#pragma unroll
    for (int j = 0; j < 3; ++j) { gq[2 * j] = qg[128 * j + 2 * lane]; gq[2 * j + 1] = qg[128 * j + 2 * lane + 1]; }
#pragma unroll
    for (int j = 0; j < 4; ++j) gk[j] = kg[4 * lane + j];
    for (int r0 = gw * 4; r0 < TT; r0 += NGW * 4) {
        unsigned wq[4][3]; v2u wk[4];
#pragma unroll
        for (int q = 0; q < 4; ++q) { const bf16* pr = P + (size_t)(r0 + q) * NINP;
#pragma unroll
            for (int j = 0; j < 3; ++j) wq[q][j] = *(const unsigned*)(pr + PC_CQ + 128 * j + 2 * lane);
            wk[q] = *(const v2u*)(pr + PC_CKV + 4 * lane); }
        __builtin_amdgcn_sched_barrier(0);
#pragma unroll
        for (int q = 0; q < 4; ++q) { const int r = r0 + q; float x[6]; float s = 0.f;
#pragma unroll
            for (int j = 0; j < 3; ++j) { x[2 * j] = bf2f(wq[q][j] & 0xffffu); x[2 * j + 1] = bf2f(wq[q][j] >> 16); s += x[2 * j] * x[2 * j] + x[2 * j + 1] * x[2 * j + 1]; }
            const float rq = 1.0f / sqrtf(wave_sum(s) * (1.f / 384.f) + EPS);
#pragma unroll
            for (int j = 0; j < 3; ++j) *(unsigned*)(CQN + (size_t)r * 384 + 128 * j + 2 * lane) = pk2(x[2 * j] * rq * gq[2 * j], x[2 * j + 1] * rq * gq[2 * j + 1]);
            const float y0 = bf2f(wk[q].x & 0xffffu), y1 = bf2f(wk[q].x >> 16), y2 = bf2f(wk[q].y & 0xffffu), y3 = bf2f(wk[q].y >> 16);
            const float rk = 1.0f / sqrtf(wave_sum(y0 * y0 + y1 * y1 + y2 * y2 + y3 * y3) * (1.f / 256.f) + EPS);
            v2u o; o.x = pk2(y0 * rk * gk[0], y1 * rk * gk[1]); o.y = pk2(y2 * rk * gk[2], y3 * rk * gk[3]);
            *(v2u*)(CKVN + (size_t)r * 256 + 4 * lane) = o; }
    }
}

__device__ __forceinline__ int hgrn_row(int b, int dir, int p) {
    if (dir == 0) return p < CTXL ? TL + b * CTXL + p : b * LAT + (p - CTXL);
    return p < CTXL ? TL + b * CTXL + (CTXL - 1 - p) : b * LAT + (LAT - 1) - (p - CTXL);
}
__device__ __forceinline__ void hgrn_out_seq(const Args& a, int l, int ch, int j, int lane_in) {
    int lane = lane_in; asm volatile("" : "+v"(lane));
    const bf16* P = (const bf16*)(a.ws + WS_BIG); const float* U = (const float*)(a.ws + WS_U); float* OF = (float*)(a.ws + WS_R1); bf16* MIX = (bf16*)(a.ws + WS_XN);
    const int dir = ch & 1, bh = ch >> 1, b = bh >> 2, h = bh & 3, task = ch * NCHUNK + j, p0 = j * CHL;
    const float lbv = ((const float*)(a.ws + WS_LB))[l * 512 + dir * 256 + h * 64 + lane];
    const int fcol = dir ? PC_FB : PC_FF; const float gain = AIN(11)[l * 64 + lane];
    float S[64];
#pragma unroll
    for (int k = 0; k < 64; ++k) S[k] = U[(size_t)task * 4096 + k * 64 + lane];
    for (int t = 0; t < CHL; ++t) {
        const int r = hgrn_row(b, dir, p0 + t); const bf16* pr = P + (size_t)r * NINP + h * 64 + lane;
        const float f = lbv + (1.0f - lbv) * sigm(bf2f(pr[fcol])); const float fc = fminf(fmaxf(f, 1e-6f), 1.0f), kk = 1.0f - f;
        const float qz = bf2f(pr[PC_Q]); const float qv = qz * sigm(qz), iz = bf2f(pr[PC_I]);
        float o = 0.f;
#pragma unroll
        for (int k = 0; k < 64; ++k) { const float fk = __shfl(fc, k), kx = __shfl(kk, k), qk = __shfl(qv, k); S[k] = fmaf(S[k], fk, kx * iz); o = fmaf(S[k], qk, o); }
        if (dir == 0) OF[(size_t)r * 256 + h * 64 + lane] = o;
        else { const float ot = o + OF[(size_t)r * 256 + h * 64 + lane]; const float rs = 1.0f / sqrtf(wave_sum(ot * ot) * (1.f / 64.f) + EPS); const float gz = bf2f(pr[PC_G]);
            MIX[(size_t)r * DM + h * 64 + lane] = (bf16)f2bf(ot * rs * gain * (gz * sigm(gz))); }
    }
}
__device__ __forceinline__ void hgrn_state_mfma(const Args& a, LAS unsigned char* wl, int l, int ch, int j, int lane) {
    typedef short bf16x8_t __attribute__((ext_vector_type(8)));
    const bf16* P = (const bf16*)(a.ws + WS_BIG); float* U = (float*)(a.ws + WS_U); float* PCp = (float*)(a.ws + WS_PC);
    const int dir = ch & 1, bh = ch >> 1, b = bh >> 2, h = bh & 3, task = ch * NCHUNK + j, p0 = j * CHL;
    const float lbv = ((const float*)(a.ws + WS_LB))[l * 512 + dir * 256 + h * 64 + lane];
    const int fcol = dir ? PC_FB : PC_FF;
    LAS unsigned short* KT = (LAS unsigned short*)wl; LAS unsigned short* VT = KT + 64 * 40;
    f32x4 acc[4][4];
#pragma unroll
    for (int i = 0; i < 4; ++i)
#pragma unroll
        for (int jj = 0; jj < 4; ++jj) acc[i][jj] = (f32x4){0.f, 0.f, 0.f, 0.f};
    float D = 1.0f; bool bad = false;
#pragma unroll
    for (int blk = 2; blk >= 0; --blk) {
        const int nval = (blk == 2) ? 2 : 32, s_lo = blk * 32; const float Dblk0 = D;
        for (int hf = 1; hf >= 0; --hf) {
            unsigned short rf[16], ri[16];
#pragma unroll
            for (int s1 = 0; s1 < 16; ++s1) { const int ss = 16 * hf + s1; const int r = hgrn_row(b, dir, p0 + s_lo + (ss < nval ? ss : 0)); const bf16* pr = P + (size_t)r * NINP + h * 64 + lane; rf[s1] = pr[fcol]; ri[s1] = pr[PC_I]; }
            __builtin_amdgcn_sched_barrier(0);
#pragma unroll
            for (int s1 = 15; s1 >= 0; --s1) { const int ss = 16 * hf + s1;
                if (ss < nval) { const float f = lbv + (1.0f - lbv) * sigm(bf2f(rf[s1])); const float fc = fminf(fmaxf(f, 1e-6f), 1.0f);
                    KT[lane * 40 + ss] = (unsigned short)f2bf((1.0f - f) * D); VT[lane * 40 + ss] = ri[s1]; D *= fc; }
                else { KT[lane * 40 + ss] = 0; VT[lane * 40 + ss] = 0; }
            }
        }
        bad |= !(D > 1e-30f * Dblk0);
        LDS_WAIT(); asm volatile("" ::: "memory");
        bf16x8_t af[4], bfr[4];
#pragma unroll
        for (int i = 0; i < 4; ++i) { af[i] = *(const LAS bf16x8_t*)(KT + (16 * i + (lane & 15)) * 40 + 8 * (lane >> 4)); bfr[i] = *(const LAS bf16x8_t*)(VT + (16 * i + (lane & 15)) * 40 + 8 * (lane >> 4)); }
#pragma unroll
        for (int i = 0; i < 4; ++i)
#pragma unroll
            for (int jj = 0; jj < 4; ++jj) acc[i][jj] = __builtin_amdgcn_mfma_f32_16x16x32_bf16(af[i], bfr[jj], acc[i][jj], 0, 0, 0);
        LDS_WAIT(); asm volatile("" ::: "memory");
    }
    float* up = U + (size_t)task * 4096;
#pragma unroll
    for (int i = 0; i < 4; ++i)
#pragma unroll
        for (int jj = 0; jj < 4; ++jj)
#pragma unroll
            for (int rg = 0; rg < 4; ++rg) up[(16 * i + 4 * (lane >> 4) + rg) * 64 + 16 * jj + (lane & 15)] = acc[i][jj][rg];
    PCp[task * 64 + lane] = D;
    if (lane == 0) ((int*)(a.ws + WS_HGF))[task] = 0;
    if (__any(bad)) { if (lane == 0) ((int*)(a.ws + WS_HGF))[task] = 1; }
}

namespace hgm {
using bf16x8 = __attribute__((ext_vector_type(8))) short;
using s16x4  = __attribute__((ext_vector_type(4))) short;
using f32x16 = __attribute__((ext_vector_type(16))) float;
__device__ __forceinline__ int crow(int r, int hi) { return (r & 3) + 8 * (r >> 2) + 4 * hi; }
__device__ __forceinline__ unsigned cvtpk(float lo, float hi) { unsigned r; asm volatile("v_cvt_pk_bf16_f32 %0, %1, %2" : "=v"(r) : "v"(lo), "v"(hi)); return r; }
__device__ __forceinline__ int v_st2(int k, int c) { const int kk = (k & ~0xC) | ((k & 4) << 1) | ((k & 8) >> 1); return ((kk >> 3) * 2 + (c >> 5)) * 512 + ((kk & 7) * 32 + (c & 31)) * 2; }
__device__ __forceinline__ int v_rd_base(int lane) { return ((lane & 3) << 3) | (((lane >> 2) & 3) << 6) | (((lane >> 4) & 1) << 5) | (((lane >> 5) & 1) << 8); }
constexpr int v_rd_off2(int d0, int ks, int half) { return ((2 * ks + half) * 2 + d0) * 512; }
template <int OFF> __device__ __forceinline__ s16x4 tr_read(int vb) { s16x4 r; asm volatile("ds_read_b64_tr_b16 %0, %1 offset:%2" : "=&v"(r) : "v"(vb), "i"(OFF) : "memory"); return r; }
}
__device__ __forceinline__ void hgrn_out_mfma(const Args& a, LAS unsigned char* wl, int l, int ch, int j, int lane_in) {
    using namespace hgm;
    int lane = lane_in; asm volatile("" : "+v"(lane));
    const bf16* P = (const bf16*)(a.ws + WS_BIG); const float* U = (const float*)(a.ws + WS_U); float* OF = (float*)(a.ws + WS_R1); bf16* MIX = (bf16*)(a.ws + WS_XN);
    const int dir = ch & 1, bh = ch >> 1, b = bh >> 2, h = bh & 3, task = ch * NCHUNK + j, p0 = j * CHL, r32 = lane & 31, hi = lane >> 5;
    const float lbv = ((const float*)(a.ws + WS_LB))[l * 512 + dir * 256 + h * 64 + lane];
    const int fcol = dir ? PC_FB : PC_FF;
    constexpr int QOFF = 0, KOFF = 5120, VOFF = 10240, EOFF = 14336, QP = 144, KBP = 80;
    const int vb = (int)(uintptr_t)(unsigned char*)(wl + VOFF) + v_rd_base(lane);
    const float g0 = AIN(11)[l * 64 + r32], g1 = AIN(11)[l * 64 + 32 + r32];
    f32x16 S[2][2];
#pragma unroll
    for (int kb = 0; kb < 2; ++kb)
#pragma unroll
        for (int d = 0; d < 2; ++d)
#pragma unroll
            for (int r = 0; r < 16; ++r) S[kb][d][r] = U[(size_t)task * 4096 + (32 * kb + crow(r, hi)) * 64 + 32 * d + r32];
    for (int blk = 0; blk < 3; ++blk) {
        const int nval = (blk == 2) ? CHL - 64 : 32, pb = p0 + 32 * blk;
        bf16x8 vch[4];
#pragma unroll
        for (int i = 0; i < 4; ++i) { const int c = lane + 64 * i, sidx = c >> 3, vc = (c & 7) * 8; const int r = hgrn_row(b, dir, pb + (sidx < nval ? sidx : 0));
            vch[i] = *(const bf16x8*)(P + (size_t)r * NINP + PC_I + h * 64 + vc); if (sidx >= nval) vch[i] = (bf16x8){0, 0, 0, 0, 0, 0, 0, 0}; }
        __builtin_amdgcn_sched_barrier(0);
#pragma unroll
        for (int i = 0; i < 4; ++i) { const int c = lane + 64 * i, sidx = c >> 3, vc = (c & 7) * 8; *(LAS bf16x8*)(wl + VOFF + v_st2(sidx, vc)) = vch[i]; }
        float e = 1.0f;
        for (int hf = 0; hf < 2; ++hf) {
            unsigned short rf[16], rq[16];
#pragma unroll
            for (int s1 = 0; s1 < 16; ++s1) { const int ss = 16 * hf + s1; const int r = hgrn_row(b, dir, pb + (ss < nval ? ss : 0)); const bf16* pr = P + (size_t)r * NINP + h * 64 + lane; rf[s1] = pr[fcol]; rq[s1] = pr[PC_Q]; }
            __builtin_amdgcn_sched_barrier(0);
#pragma unroll
            for (int s1 = 0; s1 < 16; ++s1) { const int ss = 16 * hf + s1;
                unsigned qb = 0u, kbits = 0u;
                if (ss < nval) { const float f = lbv + (1.0f - lbv) * sigm(bf2f(rf[s1])); const float fc = fminf(fmaxf(f, 1e-6f), 1.0f); e *= fc;
                    const float qz = bf2f(rq[s1]); qb = f2bf(qz * sigm(qz) * e); kbits = f2bf((1.0f - f) * __builtin_amdgcn_rcpf(fmaxf(e, 1e-35f))); }
                *(LAS unsigned short*)(wl + QOFF + ss * QP + 2 * lane) = (unsigned short)qb; *(LAS unsigned short*)(wl + KOFF + ss * QP + 2 * lane) = (unsigned short)kbits;
            }
        }
        LDS_WAIT(); asm volatile("" ::: "memory");
        f32x16 p = {};
#pragma unroll
        for (int ks = 0; ks < 4; ++ks) { const bf16x8 af = *(const LAS bf16x8*)(wl + KOFF + r32 * QP + (16 * ks + 8 * hi) * 2), bq = *(const LAS bf16x8*)(wl + QOFF + r32 * QP + (16 * ks + 8 * hi) * 2);
            p = __builtin_amdgcn_mfma_f32_32x32x16_bf16(af, bq, p, 0, 0, 0); }
#pragma unroll
        for (int r = 0; r < 16; ++r) if (crow(r, hi) > r32) p[r] = 0.f;
        bf16x8 pa0, pa1;
#define HG_PK4(PP, BASE, OUT) do { unsigned a0 = cvtpk(PP[BASE + 0], PP[BASE + 1]), a1 = cvtpk(PP[BASE + 2], PP[BASE + 3]); unsigned b0 = cvtpk(PP[BASE + 4], PP[BASE + 5]), b1 = cvtpk(PP[BASE + 6], PP[BASE + 7]); \
    auto q0 = __builtin_amdgcn_permlane32_swap(a0, b0, false, false); auto q1 = __builtin_amdgcn_permlane32_swap(a1, b1, false, false); v4u w = {q0[0], q1[0], q0[1], q1[1]}; OUT = *reinterpret_cast<bf16x8*>(&w); } while (0)
        HG_PK4(p, 0, pa0); HG_PK4(p, 8, pa1);
#undef HG_PK4
#define HG_PK(L_, H_) (bf16x8){L_[0], L_[1], L_[2], L_[3], H_[0], H_[1], H_[2], H_[3]}
#define HG_VFRAGS() do { const s16x4 l00 = tr_read<v_rd_off2(0, 0, 0)>(vb), h00 = tr_read<v_rd_off2(0, 0, 1)>(vb), l01 = tr_read<v_rd_off2(0, 1, 0)>(vb), h01 = tr_read<v_rd_off2(0, 1, 1)>(vb); \
          const s16x4 l10 = tr_read<v_rd_off2(1, 0, 0)>(vb), h10 = tr_read<v_rd_off2(1, 0, 1)>(vb), l11 = tr_read<v_rd_off2(1, 1, 0)>(vb), h11 = tr_read<v_rd_off2(1, 1, 1)>(vb); \
          asm volatile("s_waitcnt lgkmcnt(0)" ::: "memory"); __builtin_amdgcn_sched_barrier(0); \
          vf[0][0] = HG_PK(l00, h00); vf[0][1] = HG_PK(l01, h01); vf[1][0] = HG_PK(l10, h10); vf[1][1] = HG_PK(l11, h11); } while (0)
        f32x16 o[2] = {};
        { bf16x8 vf[2][2]; HG_VFRAGS();
#pragma unroll
        for (int d = 0; d < 2; ++d) { o[d] = __builtin_amdgcn_mfma_f32_32x32x16_bf16(pa0, vf[d][0], o[d], 0, 0, 0); o[d] = __builtin_amdgcn_mfma_f32_32x32x16_bf16(pa1, vf[d][1], o[d], 0, 0, 0); } }
#pragma unroll
        for (int kb = 0; kb < 2; ++kb)
#pragma unroll
            for (int s2 = 0; s2 < 2; ++s2) {
                const v2u qa = *(const LAS v2u*)(wl + QOFF + r32 * QP + (32 * kb + 16 * s2 + 4 * hi) * 2), qb2 = *(const LAS v2u*)(wl + QOFF + r32 * QP + (32 * kb + 16 * s2 + 8 + 4 * hi) * 2);
                v4u qw = {qa.x, qa.y, qb2.x, qb2.y}; const bf16x8 af = *reinterpret_cast<bf16x8*>(&qw);
#pragma unroll
                for (int d = 0; d < 2; ++d) { v4u sw = {cvtpk(S[kb][d][8 * s2 + 0], S[kb][d][8 * s2 + 1]), cvtpk(S[kb][d][8 * s2 + 2], S[kb][d][8 * s2 + 3]), cvtpk(S[kb][d][8 * s2 + 4], S[kb][d][8 * s2 + 5]), cvtpk(S[kb][d][8 * s2 + 6], S[kb][d][8 * s2 + 7])};
                    o[d] = __builtin_amdgcn_mfma_f32_32x32x16_bf16(af, *reinterpret_cast<bf16x8*>(&sw), o[d], 0, 0, 0); }
            }
        asm volatile("" ::: "memory");
        float Dk = 1.0f;
        for (int hf = 1; hf >= 0; --hf) {
            unsigned short rf[16], ri[16];
#pragma unroll
            for (int s1 = 0; s1 < 16; ++s1) { const int ss = 16 * hf + s1; const int r = hgrn_row(b, dir, pb + (ss < nval ? ss : 0)); const bf16* pr = P + (size_t)r * NINP + h * 64 + lane; rf[s1] = pr[fcol]; ri[s1] = pr[PC_I]; }
            __builtin_amdgcn_sched_barrier(0);
#pragma unroll
            for (int s1 = 15; s1 >= 0; --s1) { const int ss = 16 * hf + s1;
                unsigned kb16 = 0u, vv16 = 0u;
                if (ss < nval) { const float f = lbv + (1.0f - lbv) * sigm(bf2f(rf[s1])); const float fc = fminf(fmaxf(f, 1e-6f), 1.0f); kb16 = f2bf((1.0f - f) * Dk); Dk *= fc; vv16 = ri[s1]; }
                *(LAS unsigned short*)(wl + KOFF + lane * KBP + 2 * ss) = (unsigned short)kb16; *(LAS unsigned short*)(wl + QOFF + lane * KBP + 2 * ss) = (unsigned short)vv16;
            }
        }
        *(LAS float*)(wl + EOFF + 4 * lane) = Dk;
        LDS_WAIT(); asm volatile("" ::: "memory");
#pragma unroll
        for (int kb = 0; kb < 2; ++kb) {
            float ev[16];
#pragma unroll
            for (int r = 0; r < 16; ++r) ev[r] = *(const LAS float*)(wl + EOFF + 4 * (32 * kb + crow(r, hi)));
#pragma unroll
            for (int d = 0; d < 2; ++d)
#pragma unroll
                for (int r = 0; r < 16; ++r) S[kb][d][r] *= ev[r];
#pragma unroll
            for (int ks = 0; ks < 2; ++ks) {
                const bf16x8 af = *(const LAS bf16x8*)(wl + KOFF + (32 * kb + r32) * KBP + (16 * ks + 8 * hi) * 2);
#pragma unroll
                for (int d = 0; d < 2; ++d) { const bf16x8 bv = *(const LAS bf16x8*)(wl + QOFF + (32 * d + r32) * KBP + (16 * ks + 8 * hi) * 2);
                    S[kb][d] = __builtin_amdgcn_mfma_f32_32x32x16_bf16(af, bv, S[kb][d], 0, 0, 0); }
            }
        }
        if (dir == 0) {
#pragma unroll
            for (int r = 0; r < 16; ++r) { const int t = crow(r, hi); if (t < nval) { float* op = OF + (size_t)hgrn_row(b, dir, pb + t) * 256 + h * 64 + r32; op[0] = o[0][r]; op[32] = o[1][r]; } }
        } else {
#pragma unroll
            for (int rb = 0; rb < 16; rb += 8) { float f0[8], f1[8]; unsigned short z0[8], z1[8];
#pragma unroll
                for (int i = 0; i < 8; ++i) { const int t = crow(rb + i, hi); const int row = hgrn_row(b, dir, pb + (t < nval ? t : 0));
                    const float* op = OF + (size_t)row * 256 + h * 64 + r32; f0[i] = op[0]; f1[i] = op[32]; const bf16* gp = P + (size_t)row * NINP + PC_G + h * 64 + r32; z0[i] = gp[0]; z1[i] = gp[32]; }
                __builtin_amdgcn_sched_barrier(0);
#pragma unroll
                for (int i = 0; i < 8; ++i) { const int t = crow(rb + i, hi); const int row = hgrn_row(b, dir, pb + (t < nval ? t : 0));
                    const float x0 = o[0][rb + i] + f0[i], x1 = o[1][rb + i] + f1[i]; float sq = x0 * x0 + x1 * x1;
                    sq += __shfl_xor(sq, 1); sq += __shfl_xor(sq, 2); sq += __shfl_xor(sq, 4); sq += __shfl_xor(sq, 8); sq += __shfl_xor(sq, 16);
                    const float rs = __builtin_amdgcn_rsqf(sq * (1.f / 64.f) + EPS); const float gz0 = bf2f(z0[i]), gz1 = bf2f(z1[i]);
                    if (t < nval) { bf16* mp = MIX + (size_t)row * DM + h * 64 + r32; mp[0] = (bf16)f2bf(x0 * rs * g0 * (gz0 * sigm(gz0))); mp[32] = (bf16)f2bf(x1 * rs * g1 * (gz1 * sigm(gz1))); } }
            }
        }
        LDS_WAIT(); asm volatile("" ::: "memory");
    }
#undef HG_VFRAGS
#undef HG_PK
}
__device__ __forceinline__ void phase_hgrn_combine(const Args& a, int tid) {
    float* U = (float*)(a.ws + WS_U); const float* PCp = (const float*)(a.ws + WS_PC);
    for (int e = blockIdx.x * 512 + tid; e < NCHAIN * 4096; e += gridDim.x * 512) {
        const int ch = e >> 12, kv = e & 4095, k = kv >> 6; float S = 0.f;
        float* up = U + (size_t)ch * NCHUNK * 4096 + kv; const float* pp = PCp + ch * NCHUNK * 64 + k;
        for (int c0 = 0; c0 < NCHUNK; c0 += 16) { float t[16], d[16];
#pragma unroll
            for (int i = 0; i < 16; ++i) { t[i] = up[(size_t)(c0 + i) * 4096]; d[i] = pp[(c0 + i) * 64]; }
#pragma unroll
            for (int i = 0; i < 16; ++i) { up[(size_t)(c0 + i) * 4096] = S; S = fmaf(d[i], S, t[i]); } }
    }
}

__device__ __forceinline__ void phase_pool(const Args& a, LAS unsigned char* lds, int l, int tid, int wave, int lane) {
    const bf16* P = (const bf16*)(a.ws + WS_BIG); bf16* MIX = (bf16*)(a.ws + WS_XN);
    LAS float* UL = (LAS float*)lds;
    LAS float* PL = (LAS float*)(lds + 80 * 256 * 4) + wave * 64;
    const int g = wave & 3, half = wave >> 2, w = 2 << g;
    float Wc[64];
    const float* pw = AIN(18) + (size_t)(l * 4 + g) * 4096 + lane;
#pragma unroll
    for (int c = 0; c < 64; ++c) Wc[c] = pw[c * 64];
    const float psc = AIN(19)[l * 256 + g * 64 + lane];
    for (int task = blockIdx.x; task < 528; task += gridDim.x) {
        int rbase, slen, t0;
        if (task < 512) { rbase = (task >> 7) * LAT; slen = LAT; t0 = (task & 127) * 64; } else { const int q = task - 512; rbase = TL + (q >> 2) * CTXL; slen = CTXL; t0 = (q & 3) * 64; }
        __syncthreads();
        for (int jb = 0; jb < 20; jb += 10) { unsigned wv[10];
#pragma unroll
            for (int j = 0; j < 10; ++j) { const int i = tid + 512 * (jb + j), row = i >> 7, cp = i & 127, t = t0 - 8 + row; const int tc = t < 0 ? 0 : (t >= slen ? slen - 1 : t);
                wv[j] = *(const unsigned*)(P + (size_t)(rbase + tc) * NINP + PC_POOL + 2 * cp); }
            __builtin_amdgcn_sched_barrier(0);
#pragma unroll
            for (int j = 0; j < 10; ++j) { const int i = tid + 512 * (jb + j), row = i >> 7, cp = i & 127, t = t0 - 8 + row; const bool ok = (t >= 0 && t < slen);
                UL[row * 256 + 2 * cp] = ok ? bf2f(wv[j] & 0xffffu) : 0.f; UL[row * 256 + 2 * cp + 1] = ok ? bf2f(wv[j] >> 16) : 0.f; } }
        __syncthreads();
        for (int tt = 0; tt < 32; ++tt) { const int tl = half * 32 + tt, t = t0 + tl;
            int lo = t - (w >> 1), hi = t + w - 1 - (w >> 1); lo = lo < 0 ? 0 : lo; hi = hi > slen - 1 ? slen - 1 : hi;
            float s = 0.f; for (int q = lo; q <= hi; ++q) s += UL[(q - t0 + 8) * 256 + g * 64 + lane];
            PL[lane] = s / (float)(hi - lo + 1) - UL[(tl + 8) * 256 + g * 64 + lane];
            LDS_WAIT(); asm volatile("" ::: "memory");
            float o0 = 0.f, o1 = 0.f, o2 = 0.f, o3 = 0.f;
#pragma unroll
            for (int c4 = 0; c4 < 16; ++c4) { const f32x4 p4 = *(const LAS f32x4*)(PL + 4 * c4);
                o0 = fmaf(p4.x, Wc[4 * c4], o0); o1 = fmaf(p4.y, Wc[4 * c4 + 1], o1); o2 = fmaf(p4.z, Wc[4 * c4 + 2], o2); o3 = fmaf(p4.w, Wc[4 * c4 + 3], o3); }
            MIX[(size_t)(rbase + t) * DM + 768 + g * 64 + lane] = (bf16)f2bf(((o0 + o1) + (o2 + o3)) * psc);
            LDS_WAIT(); asm volatile("" ::: "memory"); }
    }
}

__device__ __forceinline__ void phase_qk_post(const Args& a, int l, int wave, int lane) {
    const bf16* P = (const bf16*)(a.ws + WS_BIG); bf16* Q = (bf16*)(a.ws + WS_Q); const bf16* KVR = (const bf16*)(a.ws + WS_KVRAW); bf16* Kb = (bf16*)(a.ws + WS_K); bf16* Vb = (bf16*)(a.ws + WS_V);
    const float* qgain = AIN(16) + l * 96; const float* kgain = AIN(17) + l * 96;
    const int h = lane >> 3, i = lane & 7;
    float gq[12], gk[12];
#pragma unroll
    for (int e = 0; e < 8; ++e) { gq[e] = qgain[i * 8 + e]; gk[e] = kgain[i * 8 + e]; }
    gq[8] = qgain[64 + 2 * i]; gq[9] = qgain[65 + 2 * i]; gq[10] = qgain[80 + 2 * i]; gq[11] = qgain[81 + 2 * i];
    gk[8] = kgain[64 + 2 * i]; gk[9] = kgain[65 + 2 * i]; gk[10] = kgain[80 + 2 * i]; gk[11] = kgain[81 + 2 * i];
    const int p0 = 2 * i; const float if0 = __builtin_amdgcn_exp2f(-(float)(p0 & 7) * (13.287712379549449f / 8.f)), if1 = __builtin_amdgcn_exp2f(-(float)((p0 + 1) & 7) * (13.287712379549449f / 8.f));
    const int gw = blockIdx.x * 8 + wave, NGW = gridDim.x * 8;
    if (gw == 0) {
        float mq = 0.f, mk = 0.f;
#pragma unroll
        for (int e = 0; e < 12; ++e) { mq = fmaxf(mq, fabsf(gq[e])); mk = fmaxf(mk, fabsf(gk[e])); }
        mq = fmaxf(mq, __shfl_xor(mq, 1)); mq = fmaxf(mq, __shfl_xor(mq, 2)); mq = fmaxf(mq, __shfl_xor(mq, 4));
        mk = fmaxf(mk, __shfl_xor(mk, 1)); mk = fmaxf(mk, __shfl_xor(mk, 2)); mk = fmaxf(mk, __shfl_xor(mk, 4));
        const float mlog2 = 1.02f * 96.0f * mq * mk * (att::SCALE * 1.4426950408889634f);
        if (lane == 0) ((float*)(a.ws + WS_ATTM))[l] = mlog2 > 40.0f ? -mlog2 : 0.0f;
    }
    for (int r0 = gw * 4; r0 < TT; r0 += NGW * 4) {
        v4u qw[4], kw[4], vw[4]; unsigned qa_[4], qb_[4], ka_[4], kb_[4];
#pragma unroll
        for (int q = 0; q < 4; ++q) { const int r = r0 + q; const bf16* qp = Q + (size_t)r * 768 + h * 96; const bf16* kp = KVR + (size_t)r * 1024 + h * 128; const bf16* pe = P + (size_t)r * NINP + PC_KPE;
            qw[q] = *(const v4u*)(qp + i * 8); qa_[q] = *(const unsigned*)(qp + 64 + 2 * i); qb_[q] = *(const unsigned*)(qp + 80 + 2 * i);
            kw[q] = *(const v4u*)(kp + i * 8); vw[q] = *(const v4u*)(kp + 64 + i * 8); ka_[q] = *(const unsigned*)(pe + 2 * i); kb_[q] = *(const unsigned*)(pe + 16 + 2 * i); }
        __builtin_amdgcn_sched_barrier(0);
#pragma unroll
        for (int q = 0; q < 4; ++q) { const int r = r0 + q;
        const bool lat = r < TL; int kvrow; float c0 = 1.f, s0 = 0.f, c1 = 1.f, s1 = 0.f;
        if (lat) { const int b = r >> 13, t = r & 8191; kvrow = b * KVS + t; const float pos = (float)(p0 < 8 ? (t >> 6) : (t & 63));
            float a0_ = pos * if0 * 0.15915494309189535f, a1_ = pos * if1 * 0.15915494309189535f; a0_ -= floorf(a0_); a1_ -= floorf(a1_);
            c0 = __builtin_amdgcn_cosf(a0_); s0 = __builtin_amdgcn_sinf(a0_); c1 = __builtin_amdgcn_cosf(a1_); s1 = __builtin_amdgcn_sinf(a1_); }
        else { const int rc = r - TL; kvrow = (rc >> 8) * KVS + LAT + (rc & 255); }
        { bf16* qp = Q + (size_t)r * 768 + h * 96; float x[12];
          const v4u w = qw[q]; const unsigned wa = qa_[q], wb = qb_[q];
          x[0] = bf2f(w.x & 0xffffu); x[1] = bf2f(w.x >> 16); x[2] = bf2f(w.y & 0xffffu); x[3] = bf2f(w.y >> 16); x[4] = bf2f(w.z & 0xffffu); x[5] = bf2f(w.z >> 16); x[6] = bf2f(w.w & 0xffffu); x[7] = bf2f(w.w >> 16);
          x[8] = bf2f(wa & 0xffffu); x[9] = bf2f(wa >> 16); x[10] = bf2f(wb & 0xffffu); x[11] = bf2f(wb >> 16);
          float s = 0.f;
#pragma unroll
          for (int e = 0; e < 12; ++e) s += x[e] * x[e];
          s += __shfl_xor(s, 1); s += __shfl_xor(s, 2); s += __shfl_xor(s, 4);
          const float rs = (att::SCALE * 1.4426950408889634f) / sqrtf(s * (1.f / 96.f) + EPS);
#pragma unroll
          for (int e = 0; e < 12; ++e) x[e] = x[e] * rs * gq[e];
          const float a0 = x[8] * c0 - x[10] * s0, b0 = x[8] * s0 + x[10] * c0, a1 = x[9] * c1 - x[11] * s1, b1 = x[9] * s1 + x[11] * c1;
          v4u o; o.x = pk2(x[0], x[1]); o.y = pk2(x[2], x[3]); o.z = pk2(x[4], x[5]); o.w = pk2(x[6], x[7]);
          *(v4u*)(qp + i * 8) = o; *(unsigned*)(qp + 64 + 2 * i) = pk2(a0, a1); *(unsigned*)(qp + 80 + 2 * i) = pk2(b0, b1); }
        { float x[12];
          const v4u w = kw[q]; const v4u vv = vw[q]; const unsigned wa = ka_[q], wb = kb_[q];
          x[0] = bf2f(w.x & 0xffffu); x[1] = bf2f(w.x >> 16); x[2] = bf2f(w.y & 0xffffu); x[3] = bf2f(w.y >> 16); x[4] = bf2f(w.z & 0xffffu); x[5] = bf2f(w.z >> 16); x[6] = bf2f(w.w & 0xffffu); x[7] = bf2f(w.w >> 16);
          x[8] = bf2f(wa & 0xffffu); x[9] = bf2f(wa >> 16); x[10] = bf2f(wb & 0xffffu); x[11] = bf2f(wb >> 16);
          float s = 0.f;
#pragma unroll
          for (int e = 0; e < 12; ++e) s += x[e] * x[e];
          s += __shfl_xor(s, 1); s += __shfl_xor(s, 2); s += __shfl_xor(s, 4);
          const float rs = 1.0f / sqrtf(s * (1.f / 96.f) + EPS);
#pragma unroll
          for (int e = 0; e < 12; ++e) x[e] = x[e] * rs * gk[e];
          const float a0 = x[8] * c0 - x[10] * s0, b0 = x[8] * s0 + x[10] * c0, a1 = x[9] * c1 - x[11] * s1, b1 = x[9] * s1 + x[11] * c1;
          bf16* ko = Kb + (size_t)kvrow * 768 + h * 96; v4u o; o.x = pk2(x[0], x[1]); o.y = pk2(x[2], x[3]); o.z = pk2(x[4], x[5]); o.w = pk2(x[6], x[7]);
          *(v4u*)(ko + i * 8) = o; *(unsigned*)(ko + 64 + 2 * i) = pk2(a0, a1); *(unsigned*)(ko + 80 + 2 * i) = pk2(b0, b1);
          *(v4u*)(Vb + (size_t)kvrow * 512 + h * 64 + i * 8) = vv; }
        }
    }
}
#define XB_TMO      128
#define XB_XCNT(j)  (256  + 64 * (j))
#define XB_XSUB(j)  (1280 + 64 * (j))
#define XB_XGEN(j)  (2304 + 64 * (j))
#define XB_TOP      3328
#define XB_TOPGEN   3392
#define XCD_BAR_WORDS 3456
#define XB_SPIN_CAP (1u << 18)

__device__ __forceinline__ unsigned xb_ld(unsigned* p)              { return __hip_atomic_load(p, __ATOMIC_RELAXED, __HIP_MEMORY_SCOPE_AGENT); }
__device__ __forceinline__ unsigned xb_add(unsigned* p, unsigned v) { return __hip_atomic_fetch_add(p, v, __ATOMIC_RELAXED, __HIP_MEMORY_SCOPE_AGENT); }
__device__ __forceinline__ unsigned xb_xcc_id() { return (unsigned)__builtin_amdgcn_s_getreg((3 << 11) | 20) & 0xFu; }
#define XB_SPIN(cond, bar) do { unsigned _sp = 0; while (cond) { __builtin_amdgcn_s_sleep(1); \
    if ((++_sp & 255u) == 0u) { if (xb_ld(&(bar)[XB_TMO])) break; if (_sp > XB_SPIN_CAP) { atomicAdd(&(bar)[XB_TMO], 1u); break; } } } } while (0)

struct XcdBarrier {
    unsigned* bar; unsigned x;
    volatile LAS unsigned* st;
};

__device__ __forceinline__ XcdBarrier xcd_barrier_post(unsigned* bar, volatile LAS unsigned* st) {
    XcdBarrier b; b.bar = bar; b.x = xb_xcc_id(); b.st = st;
    if (threadIdx.x == 0) (void)xb_add(&bar[XB_XCNT(b.x)], 1u);
    return b;
}
__device__ __forceinline__ void xcd_barrier_complete(unsigned* bar, unsigned x, unsigned& nloc, unsigned& nx) {
    const unsigned G = gridDim.x * gridDim.y * gridDim.z;
    unsigned sum, cnt, mine, sp = 0u;
    for (;;) {
        sum = 0u; cnt = 0u; mine = 0u;
#pragma unroll
        for (unsigned j = 0; j < 16; ++j) { const unsigned c = xb_ld(&bar[XB_XCNT(j)]); sum += c; cnt += (c > 0u) ? 1u : 0u; mine = (j == x) ? c : mine; }
        if (sum == G) break;
        __builtin_amdgcn_s_sleep(1);
        if ((++sp & 255u) == 0u) { if (xb_ld(&bar[XB_TMO])) break; if (sp > XB_SPIN_CAP) { atomicAdd(&bar[XB_TMO], 1u); break; } }
    }
    nloc = mine > 0u ? mine : 1u; nx = cnt > 0u ? cnt : 1u;
}

__device__ __forceinline__ void xcd_barrier(const XcdBarrier& b) {
    asm volatile("s_waitcnt vmcnt(0)" ::: "memory");
    __syncthreads();
    if (threadIdx.x == 0) {
        unsigned* bar = b.bar;
        __builtin_amdgcn_s_waitcnt(0);
        unsigned nloc = b.st[0], nx = b.st[1];
        if (nloc == 0u) { xcd_barrier_complete(bar, b.x, nloc, nx); b.st[0] = nloc; b.st[1] = nx; }
        const unsigned old = xb_add(&bar[XB_XSUB(b.x)], 1u);
        const unsigned gen = old / nloc;
        if (old + 1u == (gen + 1u) * nloc) {
            __builtin_amdgcn_fence(__ATOMIC_RELEASE, "agent");
            asm volatile("s_waitcnt vmcnt(0)" ::: "memory");
            const unsigned og = xb_add(&bar[XB_TOP], 1u);
            const unsigned tg = og / nx;
            if (og + 1u == (tg + 1u) * nx) xb_add(&bar[XB_TOPGEN], 1u);
            else XB_SPIN(xb_ld(&bar[XB_TOPGEN]) == tg, bar);
            __builtin_amdgcn_fence(__ATOMIC_ACQUIRE, "agent");
            xb_add(&bar[XB_XGEN(b.x)], 1u);
            asm volatile("s_waitcnt vmcnt(0)" ::: "memory");
        } else {
            XB_SPIN(xb_ld(&bar[XB_XGEN(b.x)]) == gen, bar);
            __builtin_amdgcn_fence(__ATOMIC_ACQUIRE, "agent");
            asm volatile("s_waitcnt vmcnt(0)" ::: "memory");
        }
    }
    __syncthreads();
}


__device__ __forceinline__ void ctx_resid_gemm(const bf16* A, const bf16* Bt, int K, float* xc, const float* gate, float coef, LAS unsigned char* lds, int tid, int wave, int lane) {
    typedef short bf16x8_t __attribute__((ext_vector_type(8)));
    for (int tile = blockIdx.x; tile < 256; tile += gridDim.x) {
        const int r0 = (tile >> 4) * 64, c0 = (tile & 15) * 64, ks = K >> 3, kbeg = wave * ks;
        const bf16* ap = A + (size_t)(r0 + (lane & 15)) * K + kbeg + 8 * (lane >> 4);
        const bf16* bp = Bt + (size_t)(c0 + (lane & 15)) * K + kbeg + 8 * (lane >> 4);
        f32x4 acc[4][4];
#pragma unroll
        for (int i = 0; i < 4; ++i)
#pragma unroll
            for (int j = 0; j < 4; ++j) acc[i][j] = (f32x4){0.f, 0.f, 0.f, 0.f};
        for (int k0 = 0; k0 < ks; k0 += 32) {
            bf16x8_t af[4], bfr[4];
#pragma unroll
            for (int i = 0; i < 4; ++i) { af[i] = *(const bf16x8_t*)(ap + (size_t)(16 * i) * K + k0); bfr[i] = *(const bf16x8_t*)(bp + (size_t)(16 * i) * K + k0); }
#pragma unroll
            for (int i = 0; i < 4; ++i)
#pragma unroll
                for (int j = 0; j < 4; ++j) acc[i][j] = __builtin_amdgcn_mfma_f32_16x16x32_bf16(af[i], bfr[j], acc[i][j], 0, 0, 0);
        }
        LAS float* pw = (LAS float*)lds + wave * (64 * 68);
        __syncthreads();
#pragma unroll
        for (int i = 0; i < 4; ++i)
#pragma unroll
            for (int j = 0; j < 4; ++j)
#pragma unroll
                for (int rg = 0; rg < 4; ++rg) pw[(16 * i + 4 * (lane >> 4) + rg) * 68 + 16 * j + (lane & 15)] = acc[i][j][rg];
        __syncthreads();
        const int row = tid >> 3, col = (tid & 7) * 8;
        f32x4 s0 = {0.f, 0.f, 0.f, 0.f}, s1 = {0.f, 0.f, 0.f, 0.f};
#pragma unroll
        for (int w = 0; w < 8; ++w) { const LAS float* q = (const LAS float*)lds + w * (64 * 68) + row * 68 + col; s0 += *(const LAS f32x4*)q; s1 += *(const LAS f32x4*)(q + 4); }
        float* xp = xc + (size_t)(r0 + row) * DM + c0 + col; const float* gp = gate + c0 + col;
        const f32x4 g0 = *(const f32x4*)gp * coef, g1 = *(const f32x4*)(gp + 4) * coef;
        const f32x4 x0 = *(const f32x4*)xp, x1 = *(const f32x4*)(xp + 4);
        *(f32x4*)xp = x0 + g0 * s0; *(f32x4*)(xp + 4) = x1 + g1 * s1;
    }
}
__device__ __forceinline__ void phase_attn(const Args& a, unsigned char* lds_generic, int l, int lane_in) {
    const bf16* Q = (const bf16*)(a.ws + WS_Q); const bf16* Kb = (const bf16*)(a.ws + WS_K); const bf16* Vb = (const bf16*)(a.ws + WS_V); bf16* MIX = (bf16*)(a.ws + WS_XN);
    const int nunits = 1024 + (l < DEPTH - 1 ? 32 : 0);
    float negM;
    negM = __uint_as_float(__builtin_amdgcn_readfirstlane(__float_as_uint(((const float*)(a.ws + WS_ATTM))[l])));
    for (int u = blockIdx.x; u < nunits; u += gridDim.x) {
        if (u < 1024) {
            const int rnd = u >> 8, w = u & 255, bh = rnd * 8 + (w & 7), qb = w >> 3, b = bh >> 3, h = bh & 7;
            const size_t qrow = (size_t)b * LAT + qb * 256;
            att::attn_body(Q + qrow * 768 + h * 96, Kb + (size_t)b * KVS * 768 + h * 96, Vb + (size_t)b * KVS * 512 + h * 64, MIX + qrow * DM + 256 + h * 64, KVS, (char*)lds_generic, negM);
        } else {
            const int bh = u - 1024, b = bh >> 3, h = bh & 7; const size_t qrow = (size_t)TL + b * CTXL;
            att::attn_body(Q + qrow * 768 + h * 96, Kb + ((size_t)b * KVS + LAT) * 768 + h * 96, Vb + ((size_t)b * KVS + LAT) * 512 + h * 64, MIX + qrow * DM + 256 + h * 64, CTXL, (char*)lds_generic, negM);
        }
    }
}

template <bool COOP>
__global__ void __launch_bounds__(512, 2) mk_fwd(Args a) {
    extern __shared__ __attribute__((aligned(16))) unsigned char lds[];
    LAS unsigned char* L = (LAS unsigned char*)lds;
    const int G = gridDim.x, NGW = G * 8;
    unsigned char* wb = a.ws + WS_W;
    if (COOP) { volatile LAS unsigned* st = (volatile LAS unsigned*)(L + LDS_BYTES - 64); if (threadIdx.x < 2) st[threadIdx.x] = 0u; __syncthreads(); (void)xcd_barrier_post((unsigned*)(a.ws + WS_BAR), st); }
    for (int ph = a.ph_lo; ph < a.ph_hi; ++ph) {
        int tid_l = threadIdx.x; asm volatile("" : "+v"(tid_l));
        const int tid = tid_l, lane = tid & 63, wave = __builtin_amdgcn_readfirstlane(tid >> 6), gw = blockIdx.x * 8 + wave;
        if (ph == 0) phase_init(a, L, tid, wave, lane);
        else {
            const int l = (ph - 1) / NPH_LAYER, k = (ph - 1) % NPH_LAYER;
            const bool last = (l == DEPTH - 1);
            const float* xl = (l == 0 && k <= 2) ? AIN(0) : a.out;
            const float* xc = (l == 0 && k <= 2) ? AIN(2) : (const float*)(a.ws + WS_XC);
            float* xc_out = (float*)(a.ws + WS_XC);
            const float* mod = (const float*)(a.ws + WS_MOD) + (size_t)l * 5 * 9216;
            const int mrows = (last && k >= 9) ? TL : TT;
            if (k == 0) { phase_wconv(a, L, l, wave, lane); phase_norm(a, l, 0, xl, xc, TT, wave, lane); }
            else if (k == 3) phase_norm(a, l, 3, xl, xc, TT, wave, lane);
            else if (k == 10) phase_norm(a, l, 6, xl, xc, mrows, wave, lane);
            else if (k == 1 || k == 11) {
                pg8::Gemm g{(const bf16*)(a.ws + WS_XN), (const bf16*)(wb + (k == 1 ? W_F1IN : W_F2IN)), mrows, 2 * FF, DM};
                pg8::StaticOrder S; S.init(mrows, 2 * FF, G, (int)blockIdx.x);
                pg8::EpiSwiglu E{(bf16*)(a.ws + WS_BIG), FF};

#ifndef NO_G1
pg8::gemm_phase<pg8::EpiSwiglu, pg8::StaticOrder, true, true>(L, g, S, E);
#endif

            }
            else if (k == 2 || k == 9 || k == 12) {
                const bool isout = (k == 9);
                const int Kd = isout ? DM : FF; const bf16* Ap = (const bf16*)(a.ws + (isout ? WS_XN : WS_BIG)); const bf16* Bp = (const bf16*)(wb + (k == 2 ? W_F1OUT : (isout ? W_OUT : W_F2OUT)));
                pg8::Gemm g{Ap, Bp, TL, DM, Kd};
                pg8::StaticOrder S; S.init(TL, DM, G, (int)blockIdx.x);
                pg8::EpiResid E{xl, xc, a.out, xc_out, mod + (k == 2 ? 2 : (isout ? 5 : 8)) * 1024, 9216, isout ? 1.0f : 0.5f};

#ifndef NO_G2
pg8::gemm_phase<pg8::EpiResid, pg8::StaticOrder, false, true>(L, g, S, E);
#endif
                if (mrows == TT) {
                    if (l == 0 && k == 2) { for (int tile = blockIdx.x; tile < 256; tile += G) { const int r = (tile >> 4) * 64 + (tid >> 3), c = (tile & 15) * 64 + (tid & 7) * 8;
                            const float* sp = xc + (size_t)r * DM + c; float* dp = xc_out + (size_t)r * DM + c; *(f32x4*)dp = *(const f32x4*)sp; *(f32x4*)(dp + 4) = *(const f32x4*)(sp + 4); } }
                    ctx_resid_gemm(Ap + (size_t)TL * Kd, Bp, Kd, xc_out, mod + 4 * 9216 + (k == 2 ? 2 : (isout ? 5 : 8)) * 1024, isout ? 1.0f : 0.5f, L, tid, wave, lane);
                }

            }
            else if (k == 4 || k == 6) {
                if (k == 6) phase_hgrn_combine(a, tid);
                const int ng = (k == 4) ? 1 : 2;
                for (int gi = 0; gi < ng; ++gi) {
                    pg8::Gemm g; pg8::EpiBf16P E;
                    if (k == 4)       { g = pg8::Gemm{(const bf16*)(a.ws + WS_XN), (const bf16*)(wb + W_IN), TT, NINP, DM}; E = pg8::EpiBf16P{(bf16*)(a.ws + WS_BIG), NINP}; }
                    else if (gi == 0) { g = pg8::Gemm{(const bf16*)(a.ws + WS_R1), (const bf16*)(wb + W_UQ), TT, 768, 384}; E = pg8::EpiBf16P{(bf16*)(a.ws + WS_Q), 768}; }
                    else              { g = pg8::Gemm{(const bf16*)(a.ws + WS_CKVN), (const bf16*)(wb + W_UKV), TT, 1024, 256}; E = pg8::EpiBf16P{(bf16*)(a.ws + WS_KVRAW), 1024}; }
                    pg8::StaticOrder S; S.init(g.M, g.N, G, (int)blockIdx.x);

#ifndef NO_G3
pg8::gemm_phase<pg8::EpiBf16P, pg8::StaticOrder, true, true>(L, g, S, E);
#endif

                }
            }
            else if (k == 5) {
                for (int rep5 = 0; rep5 < PROBE_REP5; ++rep5) {
                phase_mla_norm(a, l, wave, lane);
                for (int t = gw; t < NCHAIN * NCHUNK; t += NGW) hgrn_state_mfma(a, L + wave * 16384, l, t / NCHUNK, t % NCHUNK, lane);
                __syncthreads();

#ifndef NO_POOL
                phase_pool(a, L, l, tid, wave, lane);
#endif
                __syncthreads(); }

            }
            else if (k == 7) {

#ifndef NO_QK
                phase_qk_post(a, l, wave, lane);
#endif

                for (int t = gw; t < (NCHAIN / 2) * NCHUNK; t += NGW) { const int chx = (t / NCHUNK) * 2, jx = t % NCHUNK;

#ifndef NO_FB
if (__builtin_amdgcn_readfirstlane(((const int*)(a.ws + WS_HGF))[chx * NCHUNK + jx])) hgrn_out_seq(a, l, chx, jx, lane);
                    else
#endif
 hgrn_out_mfma(a, L + wave * 16384, l, chx, jx, lane); }
            }
            else if (k == 8) {

#ifndef NO_ATTN
                for (int rep = 0; rep < PROBE_ATTN_REP; ++rep) phase_attn(a, lds, l, lane);
#endif

                __syncthreads();
                for (int t = gw; t < (NCHAIN / 2) * NCHUNK; t += NGW) { const int chx = (t / NCHUNK) * 2 + 1, jx = t % NCHUNK;

#ifndef NO_FB
if (__builtin_amdgcn_readfirstlane(((const int*)(a.ws + WS_HGF))[chx * NCHUNK + jx])) hgrn_out_seq(a, l, chx, jx, lane);
                    else
#endif
 hgrn_out_mfma(a, L + wave * 16384, l, chx, jx, lane); }
            }
        }
        if (COOP) { if (ph + 1 < a.ph_hi) { if (ph == a.ph_lo) cg::this_grid().sync(); else { XcdBarrier bar; bar.bar = (unsigned*)(a.ws + WS_BAR); bar.x = xb_xcc_id(); bar.st = (volatile LAS unsigned*)(L + LDS_BYTES - 64); xcd_barrier(bar); } } }
        else __syncthreads();
    }
}

#ifndef PROBE_ATTN_REP
#define PROBE_ATTN_REP 1
#endif
#ifndef MK_LAUNCH_PER_PHASE
#define MK_LAUNCH_PER_PHASE 0
#endif
extern "C" void kernel_launch(void* const* d_in, const int* in_sizes, int n_in, void* d_out, int out_size, void* d_ws, size_t ws_size, hipStream_t stream) {
    static int grid = 0;
    if (grid == 0) {
        if (n_in != 22 || in_sizes[0] != TL * DM || out_size != TL * DM || ws_size < WS_END) { fprintf(stderr, "kernel_launch: shape/workspace mismatch (n_in %d, ws %zu, need %zu); nothing launched\n", n_in, ws_size, (size_t)WS_END); grid = -1; return; }
        int dev = 0, cus = 0, per_cu = 0;
        if (hipGetDevice(&dev) != hipSuccess || hipDeviceGetAttribute(&cus, hipDeviceAttributeMultiprocessorCount, dev) != hipSuccess) { grid = -1; return; }
        if (hipFuncSetAttribute((const void*)mk_fwd<true>, hipFuncAttributeMaxDynamicSharedMemorySize, LDS_BYTES) != hipSuccess ||
            hipFuncSetAttribute((const void*)mk_fwd<false>, hipFuncAttributeMaxDynamicSharedMemorySize, LDS_BYTES) != hipSuccess) { fprintf(stderr, "kernel_launch: hipFuncSetAttribute failed\n"); grid = -1; return; }
        if (hipOccupancyMaxActiveBlocksPerMultiprocessor(&per_cu, (const void*)mk_fwd<true>, 512, LDS_BYTES) != hipSuccess || per_cu < 1) { fprintf(stderr, "kernel_launch: occupancy query says %d blocks per CU\n", per_cu); per_cu = 1; }
        (void)hipGetLastError();
        grid = cus;
    }
    if (grid < 0) return;
    Args a{};
    for (int i = 0; i < 22; ++i) a.in[i] = (const float*)d_in[i];
    a.out = (float*)d_out; a.ws = (unsigned char*)d_ws;
#if MK_LAUNCH_PER_PHASE
    for (int ph = 0; ph < NPHASES; ++ph) { a.ph_lo = ph; a.ph_hi = ph + 1; hipLaunchKernelGGL(mk_fwd<false>, dim3(grid), dim3(512), LDS_BYTES, stream, a); }
#else
    a.ph_lo = 0; a.ph_hi = NPHASES;
    if (hipMemsetAsync((char*)d_ws + WS_BAR, 0, WS_BAR_BYTES, stream) != hipSuccess) { fprintf(stderr, "kernel_launch: barrier memset failed\n"); return; }
    void* args[] = {&a};
    hipError_t e = hipLaunchCooperativeKernel((const void*)mk_fwd<true>, dim3(grid), dim3(512), args, LDS_BYTES, stream);
    if (e != hipSuccess) fprintf(stderr, "kernel_launch: cooperative launch failed: %s (grid %d)\n", hipGetErrorString(e), grid);
#endif
}
```
